# Optimizing an MI355X kernel written in HIP

```python
import math
import jax, jax.numpy as jnp
from jax import lax
import numpy as np

D_MODEL = 1024
BATCH = 4
SEQ = 8192
DEPTH = 1

ROPE_THETA = 10000.0
RMS_EPS = 1e-6
NEG_INF = -1e30

MLA_HEADS = 8
MLA_Q_RANK = 256
MLA_KV_RANK = 128
MLA_NOPE_DIM = 64
MLA_ROPE_DIM = 32
MLA_V_DIM = 64
MLA_QK_DIM = MLA_NOPE_DIM + MLA_ROPE_DIM
MLA_WIDTH = MLA_HEADS * MLA_V_DIM
Q_BLOCK = 128

DIL_CONFIGS = ((128, 1), (512, 4), (2048, 16))
DIL_GROUPS = len(DIL_CONFIGS)
DIL_HEADS_PER_GROUP = 8
DIL_HEAD_DIM = 64
DIL_HEADS = DIL_GROUPS * DIL_HEADS_PER_GROUP
DIL_QKV_WIDTH = DIL_HEADS * DIL_HEAD_DIM
DIL_WIDTH = DIL_HEADS_PER_GROUP * DIL_HEAD_DIM

IN_SPLITS = (MLA_Q_RANK, MLA_KV_RANK, MLA_ROPE_DIM, MLA_WIDTH,
             DIL_QKV_WIDTH, DIL_QKV_WIDTH, DIL_QKV_WIDTH, DIL_WIDTH,
             D_MODEL, D_MODEL)
IN_WIDTH = sum(IN_SPLITS)

kernel_name = "hybrid_mla_dilated_gated_encoder"


def rmsnorm(x, g):
    xf = x.astype(jnp.float32)
    xf = xf * lax.rsqrt(jnp.mean(xf * xf, axis=-1, keepdims=True) + RMS_EPS)
    return xf.astype(x.dtype) * g


def rope(t, positions):
    dim = t.shape[-1]
    inv_freq = ROPE_THETA ** (-jnp.arange(0, dim, 2, dtype=jnp.float32) / dim)
    ang = positions.astype(jnp.float32)[..., None] * inv_freq
    ang = jnp.concatenate([ang, ang], axis=-1)[:, :, None, :]
    cos, sin = jnp.cos(ang).astype(t.dtype), jnp.sin(ang).astype(t.dtype)
    t1, t2 = t[..., : dim // 2], t[..., dim // 2:]
    rot = jnp.concatenate([-t2, t1], axis=-1)
    return t * cos + rot * sin


def mla_attention(c_q, c_kv, k_rope, positions, q_norm_g, kv_norm_g, w_uq, w_ukv):
    B, S, _ = c_q.shape
    q = (rmsnorm(c_q, q_norm_g) @ w_uq).reshape(B, S, MLA_HEADS, MLA_QK_DIM)
    q = jnp.concatenate([q[..., :MLA_NOPE_DIM], rope(q[..., MLA_NOPE_DIM:], positions)], axis=-1)
    q = q * (MLA_QK_DIM ** -0.5)
    kv = (rmsnorm(c_kv, kv_norm_g) @ w_ukv).reshape(B, S, MLA_HEADS, MLA_NOPE_DIM + MLA_V_DIM)
    k_nope, v = kv[..., :MLA_NOPE_DIM], kv[..., MLA_NOPE_DIM:]
    k_pe = rope(k_rope[:, :, None, :], positions)
    k = jnp.concatenate([k_nope, jnp.broadcast_to(k_pe, (B, S, MLA_HEADS, MLA_ROPE_DIM))], axis=-1)
    n_blk = S // Q_BLOCK
    qb = q.reshape(B, n_blk, Q_BLOCK, MLA_HEADS, MLA_QK_DIM).transpose(1, 0, 2, 3, 4)

    def one_block(q_blk):
        s = jnp.einsum('bqhd,bkhd->bhqk', q_blk, k).astype(jnp.float32)
        p = jax.nn.softmax(s, axis=-1).astype(v.dtype)
        return jnp.einsum('bhqk,bkhd->bqhd', p, v)

    out = lax.map(one_block, qb)
    return out.transpose(1, 0, 2, 3, 4).reshape(B, S, MLA_WIDTH)


def dilated_group(q, k, v, dilation, side):
    B, S, H, D = q.shape
    L = S // dilation
    nb = -(-L // side)
    Lp = nb * side

    def to_sub(t):
        t = t.reshape(B, L, dilation, H, D).transpose(0, 2, 3, 1, 4)
        return jnp.pad(t, ((0, 0), (0, 0), (0, 0), (0, Lp - L), (0, 0)))

    def neighbourhood(t):
        tp = jnp.pad(t, ((0, 0), (0, 0), (0, 0), (side, side), (0, 0)))
        tb = tp.reshape(B, dilation, H, nb + 2, side, D)
        return jnp.concatenate([tb[:, :, :, :-2], tb[:, :, :, 1:-1], tb[:, :, :, 2:]], axis=4)

    qb = to_sub(q).reshape(B, dilation, H, nb, side, D)
    kb = neighbourhood(to_sub(k))
    vb = neighbourhood(to_sub(v))
    a = jnp.arange(side)[:, None]
    c = jnp.arange(3 * side)[None, :]
    key_pos = (jnp.arange(nb)[:, None, None] - 1) * side + c[None]
    valid = (c >= a)[None] & (c <= a + 2 * side)[None] & (key_pos >= 0) & (key_pos < L)
    s = jnp.einsum('brhnqd,brhnkd->brhnqk', qb, kb).astype(jnp.float32) * (D ** -0.5)
    s = jnp.where(valid, s, NEG_INF)
    m = jnp.max(s, axis=-1, keepdims=True)
    p = jnp.exp(s - m)
    den = jnp.sum(p, axis=-1)
    o = jnp.einsum('brhnqk,brhnkd->brhnqd', p.astype(v.dtype), vb).astype(jnp.float32) / den[..., None]
    lse = m[..., 0] + jnp.log(den)
    o = o.reshape(B, dilation, H, Lp, D)[:, :, :, :L].transpose(0, 3, 1, 2, 4).reshape(B, S, H, D)
    lse = lse.reshape(B, dilation, H, Lp)[:, :, :, :L].transpose(0, 3, 1, 2).reshape(B, S, H)
    return o, lse


def dilated_mixture(q, k, v, positions):
    B, S, _ = q.shape
    q = rope(q.reshape(B, S, DIL_HEADS, DIL_HEAD_DIM), positions)
    k = rope(k.reshape(B, S, DIL_HEADS, DIL_HEAD_DIM), positions)
    v = v.reshape(B, S, DIL_HEADS, DIL_HEAD_DIM)
    outs, lses = [], []
    for g, (window, dilation) in enumerate(DIL_CONFIGS):
        sl = slice(g * DIL_HEADS_PER_GROUP, (g + 1) * DIL_HEADS_PER_GROUP)
        o, lse = dilated_group(q[:, :, sl], k[:, :, sl], v[:, :, sl], dilation, window // (2 * dilation))
        outs.append(o)
        lses.append(lse)
    outs = jnp.stack(outs, axis=0)
    alpha = jax.nn.softmax(jnp.stack(lses, axis=0), axis=0)
    out = jnp.sum(alpha[..., None] * outs, axis=0)
    return out.reshape(B, S, DIL_WIDTH).astype(q.dtype)


def hybrid_layer(x, positions, attn_norm_g, w_in, b_gate, mla_q_norm_g, mla_kv_norm_g,
                 w_uq, w_ukv, w_o_mla, w_o_dil, w_out):
    h = rmsnorm(x, attn_norm_g)
    proj = h @ w_in
    split_points = [int(p) for p in np.cumsum(IN_SPLITS)[:-1]]
    (c_q, c_kv, k_rope, z_mla, q_dil, k_dil, v_dil, z_dil,
     g_mla, g_dil) = jnp.split(proj, split_points, axis=-1)
    a_out = mla_attention(c_q, c_kv, k_rope, positions, mla_q_norm_g, mla_kv_norm_g, w_uq, w_ukv)
    y_mla = (a_out * jax.nn.silu(z_mla)) @ w_o_mla
    d_out = dilated_mixture(q_dil, k_dil, v_dil, positions)
    y_dil = (d_out * jax.nn.silu(z_dil)) @ w_o_dil
    gate_mla = jax.nn.sigmoid(g_mla + b_gate[:D_MODEL])
    gate_dil = jax.nn.sigmoid(g_dil + b_gate[D_MODEL:])
    merged = gate_mla * y_mla + gate_dil * y_dil
    return x + merged @ w_out


def setup_inputs(seed: int = 0) -> dict:
    key = jax.random.key(seed)
    ks = jax.random.split(key, 14)
    f32 = jnp.float32

    def normal(k, shape, fan_in):
        return jax.random.normal(k, shape, f32) * fan_in ** -0.5

    def gain(k, shape):
        return 1.0 + 0.02 * jax.random.normal(k, shape, f32)

    x = jax.random.normal(ks[0], (BATCH, SEQ, D_MODEL), f32)
    positions = jnp.broadcast_to(jnp.arange(SEQ, dtype=jnp.int32)[None, :], (BATCH, SEQ))
    return {
        "x": x,
        "positions": positions,
        "attn_norm_g": gain(ks[1], (DEPTH, D_MODEL)),
        "w_in": normal(ks[2], (DEPTH, D_MODEL, IN_WIDTH), D_MODEL),
        "b_gate": 0.02 * jax.random.normal(ks[3], (DEPTH, 2 * D_MODEL), f32),
        "mla_q_norm_g": gain(ks[4], (DEPTH, MLA_Q_RANK)),
        "mla_kv_norm_g": gain(ks[5], (DEPTH, MLA_KV_RANK)),
        "w_uq": normal(ks[6], (DEPTH, MLA_Q_RANK, MLA_HEADS * MLA_QK_DIM), MLA_Q_RANK),
        "w_ukv": normal(ks[7], (DEPTH, MLA_KV_RANK, MLA_HEADS * (MLA_NOPE_DIM + MLA_V_DIM)), MLA_KV_RANK),
        "w_o_mla": normal(ks[8], (DEPTH, MLA_WIDTH, D_MODEL), MLA_WIDTH),
        "w_o_dil": normal(ks[9], (DEPTH, DIL_WIDTH, D_MODEL), DIL_WIDTH),
        "w_out": normal(ks[10], (DEPTH, D_MODEL, D_MODEL), D_MODEL),
        "final_norm_g": gain(ks[11], (D_MODEL,)),
    }


def reference(x, positions, attn_norm_g, w_in, b_gate, mla_q_norm_g, mla_kv_norm_g,
              w_uq, w_ukv, w_o_mla, w_o_dil, w_out, final_norm_g):
    h = x
    for layer in range(DEPTH):
        h = hybrid_layer(h, positions, attn_norm_g[layer], w_in[layer], b_gate[layer],
                         mla_q_norm_g[layer], mla_kv_norm_g[layer], w_uq[layer], w_ukv[layer],
                         w_o_mla[layer], w_o_dil[layer], w_out[layer])
    return rmsnorm(h, final_norm_g)
```

```cpp
#include <hip/hip_runtime.h>
#include <hip/hip_cooperative_groups.h>
#include <cstdio>
#include <cstdint>
#include <cmath>
namespace cg = cooperative_groups;

#ifndef N_LAUNCH_PER_PHASE
#define N_LAUNCH_PER_PHASE 0
#endif

#define LAS __attribute__((address_space(3)))
typedef unsigned short bf16_t;
using bf16x8 = __attribute__((ext_vector_type(8))) short;
using s16x4  = __attribute__((ext_vector_type(4))) short;
using f32x4  = __attribute__((ext_vector_type(4))) float;
using f32x16 = __attribute__((ext_vector_type(16))) float;
using u32x4  = __attribute__((ext_vector_type(4))) unsigned;
using u32x2  = __attribute__((ext_vector_type(2))) unsigned;

constexpr int SEQ = 8192, NBATCH = 4, DM = 1024, NTOK = NBATCH * SEQ, INW = 8096;
constexpr int NTHREADS = 512;
constexpr float RMS_EPS = 1e-6f;
constexpr float LOG2E = 1.4426950408889634f;
constexpr size_t MiB = 1ull << 20;
constexpr size_t WS_WIN = 0, WS_WUQ = 16 * MiB, WS_WUKV = WS_WUQ + MiB / 2, WS_WOM = 17 * MiB, WS_WOD = 18 * MiB, WS_WOUT = 19 * MiB,
                 WS_LSE = 21 * MiB, WS_COS = 24 * MiB, WS_SIN = 28 * MiB, WS_ZD = 32 * MiB, WS_A2 = 64 * MiB, WS_A1 = 96 * MiB,
                 WS_QD = 128 * MiB, WS_KD = 224 * MiB, WS_VD = 320 * MiB, WS_OG = 416 * MiB, WS_END = 512 * MiB,
                 WS_CQ = 128 * MiB, WS_CKVR = 144 * MiB, WS_ZM = 160 * MiB, WS_MQ = 192 * MiB, WS_MK = 240 * MiB, WS_MV = 288 * MiB,
                 WS_GM = 320 * MiB, WS_GD = 384 * MiB, WS_MERGED = 128 * MiB;
constexpr int LDS_BYTES = 131072 + 2048;
constexpr int LDS_MISC = 131072;

struct Params {
  const float* x; const int* pos; const float* attn_g; const float* w_in; const float* b_gate; const float* gq; const float* gkv;
  const float* w_uq; const float* w_ukv; const float* w_om; const float* w_od; const float* w_out; const float* final_g;
  float* out; unsigned char* ws;
  float inv_freq[32];
};

extern __shared__ __attribute__((aligned(16))) unsigned char smem[];

__device__ __forceinline__ unsigned cvtpk(float lo, float hi) {
  unsigned r; asm volatile("v_cvt_pk_bf16_f32 %0, %1, %2" : "=v"(r) : "v"(lo), "v"(hi)); return r;
}
__device__ __forceinline__ float bf2f(unsigned short v) { return __uint_as_float(((unsigned)v) << 16); }
__device__ __forceinline__ float bflo(unsigned w) { return __uint_as_float(w << 16); }
__device__ __forceinline__ float bfhi(unsigned w) { return __uint_as_float(w & 0xffff0000u); }
__device__ __forceinline__ float sigmoidf_(float v) { return 1.f / (1.f + __expf(-v)); }
__device__ __forceinline__ float wave_sum(float v) {
#pragma unroll
  for (int o = 32; o > 0; o >>= 1) v += __shfl_xor(v, o);
  return v;
}
__device__ __forceinline__ int otid() { int t = threadIdx.x; asm volatile("" : "+v"(t)); return t; }
__device__ __forceinline__ int vcu_id() { const int bx = blockIdx.x, G = gridDim.x; return (G % 8 == 0) ? (bx % 8) * (G / 8) + bx / 8 : bx; }

constexpr int BK = 64, HTB = 128 * BK * 2;
__device__ __forceinline__ int lds_byte(int r, int c) {
  int st = (r >> 4) * 2 + (c >> 5), rr = r & 15, cc = c & 31, ob = rr * 64 + cc * 2;
  return st * 1024 + (ob ^ (((ob >> 9) & 1) << 5));
}
__device__ __forceinline__ void stage_rc(int b, int& R, int& C) {
  int st = b / 1024, sb = b % 1024, swz = sb ^ (((sb >> 9) & 1) << 5);
  R = (st >> 1) * 16 + swz / 64; C = (st & 1) * 32 + (swz % 64) / 2;
}

enum { M_IN = 0, M_UQ = 1, M_UKV = 2, M_OUT1 = 3, M_OUT2 = 4, M_FINAL = 5 };

__device__ __forceinline__ void st4bf(bf16_t* p, f32x4 v) { u32x2 w; w.x = cvtpk(v[0], v[1]); w.y = cvtpk(v[2], v[3]); *(u32x2*)p = w; }

template <int TYPE>
__device__ __forceinline__ void epi_in(const Params& P, const f32x4 (&acc)[2][2][4][2], bf16_t* dst, const int ld, const int col0, const float* bias, const float qs,
                                       const int row0, const int wc, const int fq) {
  const float* cosT = (const float*)(P.ws + WS_COS); const float* sinT = (const float*)(P.ws + WS_SIN);
  const int fi = (wc & 1) * 16 + fq * 4;
#pragma unroll
  for (int ai = 0; ai < 2; ++ai)
#pragma unroll
    for (int m = 0; m < 4; ++m) {
      const int row = row0 + ai * 128 + m * 16;
      f32x4 cs = {1.f, 1.f, 1.f, 1.f}, sn = {0.f, 0.f, 0.f, 0.f};
      if constexpr (TYPE == 3) { cs = *(const f32x4*)(cosT + (size_t)row * 32 + fi); sn = *(const f32x4*)(sinT + (size_t)row * 32 + fi); }
#pragma unroll
      for (int bj = 0; bj < 2; ++bj) {
        const int lc = (bj * 2 + (wc >> 1)) * 64 + fi;
        f32x4 v0 = acc[ai][bj][m][0], v1 = acc[ai][bj][m][1];
        if constexpr (TYPE == 1) {
#pragma unroll
          for (int j = 0; j < 4; ++j) { v0[j] = v0[j] * sigmoidf_(v0[j]); v1[j] = v1[j] * sigmoidf_(v1[j]); }
        } else if constexpr (TYPE == 2) {
          const f32x4 b0 = *(const f32x4*)(bias + lc), b1 = *(const f32x4*)(bias + lc + 32);
#pragma unroll
          for (int j = 0; j < 4; ++j) { v0[j] = sigmoidf_(v0[j] + b0[j]); v1[j] = sigmoidf_(v1[j] + b1[j]); }
        } else if constexpr (TYPE == 3) {
#pragma unroll
          for (int j = 0; j < 4; ++j) { const float a = v0[j], b = v1[j]; v0[j] = (a * cs[j] - b * sn[j]) * qs; v1[j] = (b * cs[j] + a * sn[j]) * qs; }
        }
        bf16_t* o = dst + (size_t)row * ld + col0 + lc;
        st4bf(o, v0); st4bf(o + 32, v1);
      }
    }
}

template <int MODE>
__device__ __forceinline__ void gemm_epilogue(const Params& P, const f32x4 (&acc)[2][2][4][2], const int pm, const int pn, const int wr, const int wc, const int fr, const int fq) {
  unsigned char* ws = P.ws;
  const int row0 = pm * 256 + wr * 64 + fr;
  if constexpr (MODE == M_IN) {
    if (pn == 0)      epi_in<0>(P, acc, (bf16_t*)(ws + WS_CQ),   256,  0,               nullptr, 1.f, row0, wc, fq);
    else if (pn == 1) epi_in<0>(P, acc, (bf16_t*)(ws + WS_CKVR), 256,  0,               nullptr, 1.f, row0, wc, fq);
    else if (pn < 4)  epi_in<1>(P, acc, (bf16_t*)(ws + WS_ZM),   512,  (pn - 2) * 256,  nullptr, 1.f, row0, wc, fq);
    else if (pn < 8)  epi_in<2>(P, acc, (bf16_t*)(ws + WS_GM),   1024, (pn - 4) * 256,  P.b_gate + (pn - 4) * 256, 1.f, row0, wc, fq);
    else if (pn < 12) epi_in<2>(P, acc, (bf16_t*)(ws + WS_GD),   1024, (pn - 8) * 256,  P.b_gate + 1024 + (pn - 8) * 256, 1.f, row0, wc, fq);
    else if (pn < 18) epi_in<3>(P, acc, (bf16_t*)(ws + WS_QD),   1536, (pn - 12) * 256, nullptr, 0.125f, row0, wc, fq);
    else if (pn < 24) epi_in<3>(P, acc, (bf16_t*)(ws + WS_KD),   1536, (pn - 18) * 256, nullptr, 1.f, row0, wc, fq);
    else if (pn < 30) epi_in<0>(P, acc, (bf16_t*)(ws + WS_VD),   1536, (pn - 24) * 256, nullptr, 1.f, row0, wc, fq);
    else              epi_in<1>(P, acc, (bf16_t*)(ws + WS_ZD),   512,  (pn - 30) * 256, nullptr, 1.f, row0, wc, fq);
  } else if constexpr (MODE == M_UQ || MODE == M_UKV) {
    const LAS float* rstd = (const LAS float*)((LAS unsigned char*)smem + LDS_MISC);
    const float* cosT = (const float*)(ws + WS_COS); const float* sinT = (const float*)(ws + WS_SIN);
    bf16_t* MQ = (bf16_t*)(ws + WS_MQ); bf16_t* MK = (bf16_t*)(ws + WS_MK); bf16_t* MV = (bf16_t*)(ws + WS_MV);
#pragma unroll
    for (int ai = 0; ai < 2; ++ai)
#pragma unroll
      for (int m = 0; m < 4; ++m) {
        const int lr = ai * 128 + wr * 64 + m * 16 + fr;
        const int row = pm * 256 + lr;
        const int b = row / SEQ, s = row % SEQ;
        const float rs = rstd[lr];
#pragma unroll
        for (int bj = 0; bj < 2; ++bj) {
          const int head = 2 * pn + bj;
          f32x4 v0 = acc[ai][bj][m][0] * rs, v1 = acc[ai][bj][m][1] * rs;
          const size_t hrow = (size_t)(b * 8 + head) * SEQ + s;
          if constexpr (MODE == M_UQ) {
            if (wc < 2) { bf16_t* o = MQ + hrow * 96 + wc * 32 + fq * 4; st4bf(o, v0); st4bf(o + 16, v1); }
            else if (wc == 2) {
#pragma unroll
              for (int j = 0; j < 4; ++j) {
                const float c = cosT[(size_t)row * 32 + 2 * (fq * 4 + j)], sn = sinT[(size_t)row * 32 + 2 * (fq * 4 + j)];
                const float a = v0[j], bb = v1[j]; v0[j] = a * c - bb * sn; v1[j] = bb * c + a * sn;
              }
              bf16_t* o = MQ + hrow * 96 + 64 + fq * 4; st4bf(o, v0); st4bf(o + 16, v1);
            }
          } else {
            if (wc < 2) { bf16_t* o = MK + hrow * 96 + wc * 32 + fq * 4; st4bf(o, v0); st4bf(o + 16, v1); }
            else        { bf16_t* o = MV + hrow * 64 + (wc - 2) * 32 + fq * 4; st4bf(o, v0); st4bf(o + 16, v1); }
          }
        }
      }
  } else if constexpr (MODE == M_OUT1 || MODE == M_OUT2) {
    const bf16_t* G = (const bf16_t*)(ws + (MODE == M_OUT1 ? WS_GM : WS_GD));
    bf16_t* Mg = (bf16_t*)(ws + WS_MERGED);
#pragma unroll
    for (int ai = 0; ai < 2; ++ai)
#pragma unroll
      for (int m = 0; m < 4; ++m) {
        const int row = row0 + ai * 128 + m * 16;
#pragma unroll
        for (int bj = 0; bj < 2; ++bj)
#pragma unroll
          for (int n = 0; n < 2; ++n) {
            const size_t idx = (size_t)row * 1024 + pn * 256 + bj * 128 + wc * 32 + n * 16 + fq * 4;
            const u32x2 g = *(const u32x2*)(G + idx);
            f32x4 v = acc[ai][bj][m][n];
            v[0] *= bflo(g.x); v[1] *= bfhi(g.x); v[2] *= bflo(g.y); v[3] *= bfhi(g.y);
            if constexpr (MODE == M_OUT2) { const u32x2 t = *(const u32x2*)(Mg + idx); v[0] += bflo(t.x); v[1] += bfhi(t.x); v[2] += bflo(t.y); v[3] += bfhi(t.y); }
            st4bf(Mg + idx, v);
          }
      }
  } else {
#pragma unroll
    for (int ai = 0; ai < 2; ++ai)
#pragma unroll
      for (int m = 0; m < 4; ++m) {
        const int row = row0 + ai * 128 + m * 16;
#pragma unroll
        for (int bj = 0; bj < 2; ++bj)
#pragma unroll
          for (int n = 0; n < 2; ++n) {
            const size_t idx = (size_t)row * 1024 + pn * 256 + bj * 128 + wc * 32 + n * 16 + fq * 4;
            const f32x4 xv = *(const f32x4*)(P.x + idx);
            *(f32x4*)(P.out + idx) = acc[ai][bj][m][n] + xv;
          }
      }
  }
}

template <int MODE>
__device__ __forceinline__ void gemm_tile(const Params& P, const bf16_t* __restrict__ A, const bf16_t* __restrict__ Bt, const int K, const int pm, const int pnb, const int pn_epi) {
  LAS unsigned char* lds = (LAS unsigned char*)smem;
  const int tid = otid(), wid = __builtin_amdgcn_readfirstlane(tid >> 6), lane = tid & 63, wr = wid >> 2, wc = wid & 3, fr = lane & 15, fq = lane >> 4;
  const int brow = pm * 256, bcol = pnb * 256;
  __syncthreads();
  if constexpr (MODE == M_UQ || MODE == M_UKV) {
    constexpr int NC = (MODE == M_UQ) ? 256 : 128;
    const int r = tid >> 1, hf = tid & 1;
    const bf16_t* ap = A + (size_t)(brow + r) * K + hf * (NC / 2);
    float ss = 0.f;
#pragma unroll
    for (int i = 0; i < NC / 16; ++i) {
      const u32x4 w = *(const u32x4*)(ap + i * 8);
#pragma unroll
      for (int e = 0; e < 4; ++e) { const float a = bflo(w[e]), b = bfhi(w[e]); ss += a * a + b * b; }
    }
    ss += __shfl_xor(ss, 1);
    if (hf == 0) ((LAS float*)(lds + LDS_MISC))[r] = rsqrtf(ss * (1.f / NC) + RMS_EPS);
  }
  unsigned goff[2];
  { int R, C; stage_rc(tid * 16, R, C); goff[0] = (unsigned)(R * K + C) * 2u; goff[1] = goff[0] + (unsigned)(64 * K) * 2u; }
#define SAO(b, h) (((b) * 2 + (h)) * HTB)
#define SBO(b, h) ((4 + (b) * 2 + (h)) * HTB)
#define STAGE(PO, BASE, br, kt) do { const char* _g = (const char*)((BASE) + (size_t)(br) * K + (size_t)(kt) * BK); \
    _Pragma("unroll") for (int _i = 0; _i < 2; ++_i) \
      __builtin_amdgcn_global_load_lds((const unsigned*)(_g + goff[_i]), (LAS unsigned*)(lds + (PO) + wid * 1024 + _i * 8192), 16, 0, 0); } while (0)
#define LDA(dst, b, h) _Pragma("unroll") for (int m = 0; m < 4; ++m) _Pragma("unroll") for (int k = 0; k < 2; ++k) \
    dst[m][k] = *(const LAS bf16x8*)(lds + SAO(b, h) + lds_byte(wr * 64 + m * 16 + fr, k * 32 + fq * 8))
#define LDB(dst, b, h) _Pragma("unroll") for (int n = 0; n < 2; ++n) _Pragma("unroll") for (int k = 0; k < 2; ++k) \
    dst[n][k] = *(const LAS bf16x8*)(lds + SBO(b, h) + lds_byte(wc * 32 + n * 16 + fr, k * 32 + fq * 8))
#define MMA(ai, bj, AT, BT) do { __builtin_amdgcn_s_setprio(1); \
    _Pragma("unroll") for (int m = 0; m < 4; ++m) _Pragma("unroll") for (int n = 0; n < 2; ++n) _Pragma("unroll") for (int k = 0; k < 2; ++k) \
      acc[ai][bj][m][n] = __builtin_amdgcn_mfma_f32_16x16x32_bf16(BT[n][k], AT[m][k], acc[ai][bj][m][n], 0, 0, 0); \
    __builtin_amdgcn_s_setprio(0); } while (0)
#define WAIT_V(n) asm volatile("s_waitcnt vmcnt(" #n ")" ::: "memory")
#define WAIT_L(n) asm volatile("s_waitcnt lgkmcnt(" #n ")" ::: "memory")
#define BAR __builtin_amdgcn_s_barrier()
#define SCHED __builtin_amdgcn_sched_barrier(0)
  f32x4 acc[2][2][4][2] = {};
  bf16x8 At[4][2], B0[2][2], B1[2][2];
  const int nt = K / BK;
  STAGE(SBO(0, 0), Bt, bcol, 0); STAGE(SAO(0, 0), A, brow, 0);
  STAGE(SBO(0, 1), Bt, bcol + 128, 0); STAGE(SAO(0, 1), A, brow + 128, 0);
  if (wr == 1) BAR;
  WAIT_V(4); BAR;
  STAGE(SBO(1, 0), Bt, bcol, 1); STAGE(SAO(1, 0), A, brow, 1); STAGE(SBO(1, 1), Bt, bcol + 128, 1);
  WAIT_V(6); BAR;
  for (int t = 0; t < nt - 2; t += 2) {
    LDB(B0, 0, 0); SCHED; LDA(At, 0, 0); STAGE(SAO(1, 1), A, brow + 128, t + 1);
    WAIT_L(8); BAR; WAIT_L(0); MMA(0, 0, At, B0); BAR; SCHED;
    LDB(B1, 0, 1); STAGE(SBO(0, 0), Bt, bcol, t + 2);
    BAR; WAIT_L(0); MMA(0, 1, At, B1); BAR;
    LDA(At, 0, 1); STAGE(SAO(0, 0), A, brow, t + 2);
    BAR; WAIT_L(0); MMA(1, 0, At, B0); BAR; SCHED;
    STAGE(SBO(0, 1), Bt, bcol + 128, t + 2);
    WAIT_V(6); BAR; MMA(1, 1, At, B1); BAR;
    LDB(B0, 1, 0); SCHED; LDA(At, 1, 0); STAGE(SAO(0, 1), A, brow + 128, t + 2);
    WAIT_L(8); BAR; WAIT_L(0); MMA(0, 0, At, B0); BAR; SCHED;
    LDB(B1, 1, 1); STAGE(SBO(1, 0), Bt, bcol, t + 3);
    BAR; WAIT_L(0); MMA(0, 1, At, B1); BAR;
    LDA(At, 1, 1); STAGE(SAO(1, 0), A, brow, t + 3);
    BAR; WAIT_L(0); MMA(1, 0, At, B0); BAR; SCHED;
    STAGE(SBO(1, 1), Bt, bcol + 128, t + 3);
    WAIT_V(6); BAR; MMA(1, 1, At, B1); BAR;
  }
  { LDB(B0, 0, 0); LDA(At, 0, 0); STAGE(SAO(1, 1), A, brow + 128, nt - 1);
    BAR; WAIT_L(0); MMA(0, 0, At, B0); BAR;
    LDB(B1, 0, 1); BAR; WAIT_L(0); MMA(0, 1, At, B1); BAR;
    LDA(At, 0, 1); WAIT_V(4); BAR; WAIT_L(0); MMA(1, 0, At, B0); MMA(1, 1, At, B1); BAR; }
  { LDB(B0, 1, 0); LDA(At, 1, 0); WAIT_V(2); BAR; WAIT_L(0); MMA(0, 0, At, B0); BAR;
    LDB(B1, 1, 1); WAIT_V(0); BAR; WAIT_L(0); MMA(0, 1, At, B1); BAR;
    LDA(At, 1, 1); BAR; WAIT_L(0); MMA(1, 0, At, B0); MMA(1, 1, At, B1); BAR; }
  if (wr == 0) BAR;
  { int l2 = lane; asm volatile("" : "+v"(l2));
    gemm_epilogue<MODE>(P, acc, pm, pn_epi, wr, wc, l2 & 15, l2 >> 4); }
#undef SAO
#undef SBO
#undef STAGE
#undef LDA
#undef LDB
#undef MMA
}

#define KSWZ(row, colB) ((row) * 256 + ((colB) ^ (((row) & 7) << 4)))
#define SBAR() __builtin_amdgcn_sched_barrier(0)
constexpr int AT_V = 64 * 64 * 2, AT_K = 64 * 256, AT_KOFF = 2 * AT_V, AT_WSOFF = 2 * AT_V + 2 * AT_K;
__device__ __forceinline__ int crow(int r, int hi) { return (r & 3) + 8 * (r >> 2) + 4 * hi; }
__device__ __forceinline__ int v_st(int k, int c) { const int kk = (k & ~0xC) | ((k & 4) << 1) | ((k & 8) >> 1); return ((kk >> 3) * 2 + (c >> 5)) * 512 + ((kk & 7) * 32 + (c & 31)) * 2; }
__device__ __forceinline__ int v_rd_base(int lane) { return ((lane & 3) << 3) | (((lane >> 2) & 3) << 6) | (((lane >> 4) & 1) << 5) | (((lane >> 5) & 1) << 8); }
constexpr int v_rd_off(int d0, int ks, int half) { return d0 * 512 + ks * 2048 + half * 1024; }
template <int OFF> __device__ __forceinline__ s16x4 tr_read(int vb) {
  s16x4 r; asm volatile("ds_read_b64_tr_b16 %0, %1 offset:%2" : "=&v"(r) : "v"(vb), "i"(OFF) : "memory"); return r;
}
template <int D0> __device__ __forceinline__ void pv_one(f32x16& od, int vb, bf16x8 pa0, bf16x8 pa1, bf16x8 pa2, bf16x8 pa3) {
  const s16x4 l0 = tr_read<v_rd_off(D0, 0, 0)>(vb), h0 = tr_read<v_rd_off(D0, 0, 1)>(vb), l1 = tr_read<v_rd_off(D0, 1, 0)>(vb), h1 = tr_read<v_rd_off(D0, 1, 1)>(vb);
  const s16x4 l2 = tr_read<v_rd_off(D0, 2, 0)>(vb), h2 = tr_read<v_rd_off(D0, 2, 1)>(vb), l3 = tr_read<v_rd_off(D0, 3, 0)>(vb), h3 = tr_read<v_rd_off(D0, 3, 1)>(vb);
  asm volatile("s_waitcnt lgkmcnt(0)" ::: "memory"); SBAR();
#define PK(L, H) (bf16x8){L[0], L[1], L[2], L[3], H[0], H[1], H[2], H[3]}
  od = __builtin_amdgcn_mfma_f32_32x32x16_bf16(pa0, PK(l0, h0), od, 0, 0, 0);
  od = __builtin_amdgcn_mfma_f32_32x32x16_bf16(pa1, PK(l1, h1), od, 0, 0, 0);
  od = __builtin_amdgcn_mfma_f32_32x32x16_bf16(pa2, PK(l2, h2), od, 0, 0, 0);
  od = __builtin_amdgcn_mfma_f32_32x32x16_bf16(pa3, PK(l3, h3), od, 0, 0, 0);
#undef PK
}
__device__ __forceinline__ void partialSM(f32x16& p0, f32x16& p1, float& m_reg, float& mn, float& alpha, const float C, const float thr_raw) {
  float pmax = p0[0];
#pragma unroll
  for (int r = 1; r < 16; ++r) pmax = fmaxf(pmax, p0[r]);
#pragma unroll
  for (int r = 0; r < 16; ++r) pmax = fmaxf(pmax, p1[r]);
  { auto rr = __builtin_amdgcn_permlane32_swap(__float_as_uint(pmax), __float_as_uint(pmax), false, false);
    pmax = fmaxf(__uint_as_float(rr[0]), __uint_as_float(rr[1])); }
  if (__builtin_expect(__all(pmax - m_reg <= thr_raw), 1)) { mn = m_reg; alpha = 1.f; }
  else { mn = fmaxf(m_reg, pmax); alpha = __builtin_amdgcn_exp2f((m_reg - mn) * C); m_reg = mn; }
  const float mnC = -mn * C;
#pragma unroll
  for (int r = 0; r < 16; ++r) p0[r] = fmaf(p0[r], C, mnC);
#pragma unroll
  for (int r = 0; r < 16; ++r) p1[r] = fmaf(p1[r], C, mnC);
#pragma unroll
  for (int r = 0; r < 16; ++r) p0[r] = __builtin_amdgcn_exp2f(p0[r]);
}
__device__ __forceinline__ void finishSM(f32x16& p0, f32x16& p1, float alpha, float& l_reg, bf16x8& pa0, bf16x8& pa1, bf16x8& pa2, bf16x8& pa3) {
#pragma unroll
  for (int r = 0; r < 16; ++r) p1[r] = __builtin_amdgcn_exp2f(p1[r]);
  float ps = 0;
#pragma unroll
  for (int r = 0; r < 16; ++r) ps += p0[r];
#pragma unroll
  for (int r = 0; r < 16; ++r) ps += p1[r];
  { auto rr = __builtin_amdgcn_permlane32_swap(__float_as_uint(ps), __float_as_uint(ps), false, false);
    ps = __uint_as_float(rr[0]) + __uint_as_float(rr[1]); }
  l_reg = l_reg * alpha + ps;
#define PK4(Pv, BASE, OUT) do { unsigned a0 = cvtpk(Pv[BASE + 0], Pv[BASE + 1]), a1 = cvtpk(Pv[BASE + 2], Pv[BASE + 3]);   \
    unsigned b0 = cvtpk(Pv[BASE + 4], Pv[BASE + 5]), b1 = cvtpk(Pv[BASE + 6], Pv[BASE + 7]);                              \
    auto r0 = __builtin_amdgcn_permlane32_swap(a0, b0, false, false); auto r1 = __builtin_amdgcn_permlane32_swap(a1, b1, false, false); \
    u32x4 w = {r0[0], r1[0], r0[1], r1[1]}; OUT = *reinterpret_cast<bf16x8*>(&w); } while (0)
  PK4(p0, 0, pa0); PK4(p0, 8, pa1); PK4(p1, 0, pa2); PK4(p1, 8, pa3);
#undef PK4
}

template <int NQ, bool MASK>
__device__ __forceinline__ void attn_body(const bf16_t* __restrict__ Qb, const long ldq, const bf16_t* __restrict__ Kh, const long ldk,
                                          const bf16_t* __restrict__ Vh, const long ldv, const int NT, const float C, const float thr_raw, const int mdelta,
                                          f32x16 (&o)[2], float& m_reg, float& l_reg) {
  LAS unsigned char* lds = (LAS unsigned char*)smem;
  const int tid = otid(), wid = __builtin_amdgcn_readfirstlane(tid >> 6), lane = tid & 63, r32 = lane & 31, hi = lane >> 5;
  LAS float* wsl = (LAS float*)(lds + AT_WSOFF) + wid * 64; LAS float* al_l = wsl + 32;
  m_reg = MASK ? -30000.f : -1e30f; l_reg = 0.f;
  o[0] = f32x16{}; o[1] = f32x16{};
  bf16x8 qr[NQ];
  const bf16_t* Qw = Qb + (long)(wid * 32 + r32) * ldq + hi * 8;
#pragma unroll
  for (int d0 = 0; d0 < NQ; ++d0) qr[d0] = *(const bf16x8*)(Qw + d0 * 16);
  int kr0, kc0, kr1 = 0, kc1 = 0;
  if constexpr (NQ == 6) { kr0 = tid / 12; kc0 = (tid % 12) * 8; const int c1 = 512 + (tid & 255); kr1 = c1 / 12; kc1 = (c1 % 12) * 8; }
  else { kr0 = tid >> 3; kc0 = (tid & 7) * 8; }
  const int vr = tid >> 3, vc = (tid & 7) * 8;
  const int kst0 = KSWZ(kr0, kc0 * 2), kst1 = KSWZ(kr1, kc1 * 2), vst = v_st(vr, vc);
  const int vb0 = (int)(unsigned)(uintptr_t)lds + v_rd_base(lane);
  struct { bf16x8 v, k0, k1; } sr_[2];
#define SLOAD(i, kk0) do { sr_[i].v = *(const bf16x8*)(Vh + (long)((kk0) + vr) * ldv + vc); sr_[i].k0 = *(const bf16x8*)(Kh + (long)((kk0) + kr0) * ldk + kc0); \
    if constexpr (NQ == 6) sr_[i].k1 = *(const bf16x8*)(Kh + (long)((kk0) + kr1) * ldk + kc1); } while (0)
#define SWRITE(b, i) do { *(LAS bf16x8*)(lds + (b) * AT_V + vst) = sr_[i].v; *(LAS bf16x8*)(lds + AT_KOFF + (b) * AT_K + kst0) = sr_[i].k0; \
    if constexpr (NQ == 6) *(LAS bf16x8*)(lds + AT_KOFF + (b) * AT_K + kst1) = sr_[i].k1; } while (0)
#define SWAIT() do { if constexpr (NQ == 6) asm volatile("s_waitcnt vmcnt(3)" ::: "memory"); else asm volatile("s_waitcnt vmcnt(2)" ::: "memory"); } while (0)
#define RESC(a) do { if (__any((a) < 1.f)) { if (hi == 0) al_l[r32] = (a); asm volatile("s_waitcnt lgkmcnt(0)" ::: "memory"); \
    _Pragma("unroll") for (int d = 0; d < 2; ++d) _Pragma("unroll") for (int r = 0; r < 16; ++r) o[d][r] *= al_l[crow(r, hi)]; } } while (0)
#define QKT(P0, P1, b, tile) do { P0 = f32x16{}; P1 = f32x16{}; \
    _Pragma("unroll") for (int d0 = 0; d0 < NQ; ++d0) { const int cb = (d0 * 16 + hi * 8) * 2; \
      const bf16x8 b0 = *(const LAS bf16x8*)(lds + AT_KOFF + (b) * AT_K + KSWZ(r32, cb)); \
      const bf16x8 b1 = *(const LAS bf16x8*)(lds + AT_KOFF + (b) * AT_K + KSWZ(32 + r32, cb)); \
      P0 = __builtin_amdgcn_mfma_f32_32x32x16_bf16(b0, qr[d0], P0, 0, 0, 0); \
      P1 = __builtin_amdgcn_mfma_f32_32x32x16_bf16(b1, qr[d0], P1, 0, 0, 0); } \
    if constexpr (MASK) { const int dl = mdelta + (tile) * 64 - (wid * 32 + r32) + 4 * hi; \
      _Pragma("unroll") for (int r = 0; r < 16; ++r) { const int dd = dl + (r & 3) + 8 * (r >> 2); \
        if ((unsigned)(dd + 64) > 128u) P0[r] = -1e30f; if ((unsigned)(dd + 96) > 128u) P1[r] = -1e30f; } } } while (0)
#define PV(b) do { pv_one<0>(o[0], vb0 + (b) * AT_V, pa0, pa1, pa2, pa3); pv_one<1>(o[1], vb0 + (b) * AT_V, pa0, pa1, pa2, pa3); } while (0)
  f32x16 pA0, pA1, pB0, pB1; float mnA, mnB, alA, alB; bf16x8 pa0, pa1, pa2, pa3;
  SLOAD(0, 0); asm volatile("s_waitcnt vmcnt(0)" ::: "memory"); SWRITE(0, 0); __syncthreads();
  QKT(pA0, pA1, 0, 0); partialSM(pA0, pA1, m_reg, mnA, alA, C, thr_raw);
  SLOAD(1, 64); if (2 < NT) SLOAD(0, 128);
  SWAIT(); SWRITE(1, 1); __syncthreads();
  for (int j = 1; j + 1 < NT; j += 2) {
    SBAR(); QKT(pB0, pB1, 1, j);
    finishSM(pA0, pA1, alA, l_reg, pa0, pa1, pa2, pa3); SBAR();
    SLOAD(1, (j + 2) * 64); SBAR();
    PV(0); partialSM(pB0, pB1, m_reg, mnB, alB, C, thr_raw);
    __syncthreads(); SWAIT(); SWRITE(0, 0);
    RESC(alB); __syncthreads();
    SBAR(); QKT(pA0, pA1, 0, j + 1);
    finishSM(pB0, pB1, alB, l_reg, pa0, pa1, pa2, pa3); SBAR();
    if (j + 3 < NT) SLOAD(0, (j + 3) * 64); SBAR();
    PV(1); partialSM(pA0, pA1, m_reg, mnA, alA, C, thr_raw);
    __syncthreads(); SWAIT(); SWRITE(1, 1);
    RESC(alA); __syncthreads();
  }
  SBAR(); QKT(pB0, pB1, 1, NT - 1);
  finishSM(pA0, pA1, alA, l_reg, pa0, pa1, pa2, pa3); SBAR();
  PV(0); partialSM(pB0, pB1, m_reg, mnB, alB, C, thr_raw);
  __syncthreads(); RESC(alB);
  finishSM(pB0, pB1, alB, l_reg, pa0, pa1, pa2, pa3); SBAR();
  PV(1);
  if (hi == 0) wsl[r32] = l_reg;
  asm volatile("s_waitcnt lgkmcnt(0)" ::: "memory");
#pragma unroll
  for (int r = 0; r < 16; ++r) { const float rl = __builtin_amdgcn_rcpf(wsl[crow(r, hi)]); o[0][r] *= rl; o[1][r] *= rl; }
#undef SLOAD
#undef SWRITE
#undef SWAIT
#undef RESC
#undef QKT
#undef PV
}

__device__ __forceinline__ int perm_in(int p) { const int g = p >> 5, n = (p >> 4) & 1, fq = (p >> 2) & 3, j = p & 3; return (g >> 1) * 64 + (g & 1) * 16 + n * 32 + fq * 4 + j; }
__device__ __forceinline__ void prep_store(bf16_t* dst, const float* W, const int ldw, const int sc, const int k0, const int kvalid, const float* g) {
  float v[8];
#pragma unroll
  for (int e = 0; e < 8; ++e) { const int k = k0 + e; float t = 0.f; if (sc >= 0 && k < kvalid) { t = W[(size_t)k * ldw + sc]; if (g) t *= g[k]; } v[e] = t; }
  u32x4 w = {cvtpk(v[0], v[1]), cvtpk(v[2], v[3]), cvtpk(v[4], v[5]), cvtpk(v[6], v[7])};
  *(u32x4*)dst = w;
}
__device__ void phase_prep(const Params& P) {
  unsigned char* ws = P.ws;
  const long gtid = (long)blockIdx.x * NTHREADS + otid(), gsz = (long)gridDim.x * NTHREADS;
  for (long it = gtid; it < 8192L * 128; it += gsz) {
    const int n = (int)(it % 8192), k8 = (int)(it / 8192);
    const int t = n >> 8, l = perm_in(n & 255);
    int sc;
    if (t == 0) sc = l;
    else if (t == 1) sc = (l < 128) ? 256 + l : (l < 160 ? 384 + (l - 128) : -1);
    else if (t < 4) sc = 416 + (t - 2) * 256 + l;
    else if (t < 8) sc = 6048 + (t - 4) * 256 + l;
    else if (t < 12) sc = 7072 + (t - 8) * 256 + l;
    else if (t < 18) sc = 928 + (t - 12) * 256 + l;
    else if (t < 24) sc = 2464 + (t - 18) * 256 + l;
    else if (t < 30) sc = 4000 + (t - 24) * 256 + l;
    else sc = 5536 + (t - 30) * 256 + l;
    prep_store((bf16_t*)(ws + WS_WIN) + (size_t)n * 1024 + k8 * 8, P.w_in, INW, sc, k8 * 8, 1024, nullptr);
  }
  for (long it = gtid; it < 1024L * 32; it += gsz) {
    const int n = (int)(it % 1024), k8 = (int)(it / 1024);
    const int t = n >> 8, p = n & 255, gi = p >> 5, nn = (p >> 4) & 1, fq = (p >> 2) & 3, j = p & 3;
    const int head = 2 * t + (gi >> 2), sub = gi & 3;
    int sc;
    if (sub < 2) sc = head * 96 + sub * 32 + nn * 16 + fq * 4 + j;
    else if (sub == 2) sc = head * 96 + 64 + nn * 16 + fq * 4 + j;
    else sc = -1;
    prep_store((bf16_t*)(ws + WS_WUQ) + (size_t)n * 256 + k8 * 8, P.w_uq, 768, sc, k8 * 8, 256, P.gq);
  }
  for (long it = gtid; it < 1024L * 32; it += gsz) {
    const int n = (int)(it % 1024), k8 = (int)(it / 1024);
    prep_store((bf16_t*)(ws + WS_WUKV) + (size_t)n * 256 + k8 * 8, P.w_ukv, 1024, n, k8 * 8, 128, P.gkv);
  }
  for (long it = gtid; it < 1024L * 64; it += gsz) {
    const int n = (int)(it % 1024), k8 = (int)(it / 1024);
    prep_store((bf16_t*)(ws + WS_WOM) + (size_t)n * 512 + k8 * 8, P.w_om, 1024, n, k8 * 8, 512, nullptr);
    prep_store((bf16_t*)(ws + WS_WOD) + (size_t)n * 512 + k8 * 8, P.w_od, 1024, n, k8 * 8, 512, nullptr);
  }
  for (long it = gtid; it < 1024L * 128; it += gsz) {
    const int n = (int)(it % 1024), k8 = (int)(it / 1024);
    prep_store((bf16_t*)(ws + WS_WOUT) + (size_t)n * 1024 + k8 * 8, P.w_out, 1024, n, k8 * 8, 1024, nullptr);
  }
  for (long it = gtid; it < (long)NTOK * 32; it += gsz) {
    const int tok = (int)(it >> 5), i = (int)(it & 31);
    const double ang = (double)P.pos[tok] * (double)P.inv_freq[i];
    double rev = ang * 0.15915494309189535; rev -= floor(rev);
    const float rf = (float)rev;
    ((float*)(ws + WS_COS))[it] = __builtin_amdgcn_cosf(rf);
    ((float*)(ws + WS_SIN))[it] = __builtin_amdgcn_sinf(rf);
  }
  {
    const int lane = otid() & 63; const long wv = gtid >> 6, nwv = gsz >> 6;
    bf16_t* H = (bf16_t*)P.out;
    f32x4 g4[4];
#pragma unroll
    for (int c = 0; c < 4; ++c) g4[c] = *(const f32x4*)(P.attn_g + c * 256 + lane * 4);
    for (long row = wv; row < NTOK; row += nwv) {
      const float* xr = P.x + row * DM; f32x4 v[4]; float ss = 0.f;
#pragma unroll
      for (int c = 0; c < 4; ++c) { v[c] = *(const f32x4*)(xr + c * 256 + lane * 4); ss += v[c][0] * v[c][0] + v[c][1] * v[c][1] + v[c][2] * v[c][2] + v[c][3] * v[c][3]; }
      ss = wave_sum(ss);
      const float rs = rsqrtf(ss * (1.f / DM) + RMS_EPS);
#pragma unroll
      for (int c = 0; c < 4; ++c) { f32x4 t = v[c] * rs * g4[c]; st4bf(H + row * DM + c * 256 + lane * 4, t); }
    }
  }
}

template <int MODE>
__device__ void phase_gemm(const Params& P, const bf16_t* A, const bf16_t* Bt, const int K, const int pn_lo, const int npn, const int pnb_lo) {
  const int nunits = (NTOK / 256) * npn;
  for (int u = vcu_id(); u < nunits; u += gridDim.x) {
    const int pm = u / npn, pl = u % npn;
    gemm_tile<MODE>(P, A, Bt, K, pm, pnb_lo + pl, pn_lo + pl);
  }
  __syncthreads();
}

__device__ void phase_dilated(const Params& P) {
  unsigned char* ws = P.ws;
  const bf16_t* QD = (const bf16_t*)(ws + WS_QD); const bf16_t* KD = (const bf16_t*)(ws + WS_KD); const bf16_t* VD = (const bf16_t*)(ws + WS_VD);
  bf16_t* OG = (bf16_t*)(ws + WS_OG); float* LSE = (float*)(ws + WS_LSE);
  const int tid = otid(), wid = tid >> 6, lane = tid & 63, r32 = lane & 31, hi = lane >> 5;
  for (int u = vcu_id(); u < 3072; u += gridDim.x) {
    const int g = u >> 10, rem = u & 1023, b = rem >> 8, h8 = (rem >> 5) & 7, xx = rem & 31;
    const int dil = (g == 0) ? 1 : (g == 1 ? 4 : 16), L = SEQ / dil;
    const int rho = xx % dil, blk = xx / dil, gh = g * 8 + h8;
    const int p0 = blk * 256;
    int t0 = p0 / 64 - 1; t0 = t0 < 0 ? 0 : t0; if (t0 > L / 64 - 6) t0 = L / 64 - 6;
    const int k0 = t0 * 64;
    const long ld = (long)dil * 1536;
    const bf16_t* Qb = QD + ((long)b * SEQ + (long)p0 * dil + rho) * 1536 + gh * 64;
    const bf16_t* Kb = KD + ((long)b * SEQ + (long)k0 * dil + rho) * 1536 + gh * 64;
    const bf16_t* Vb = VD + ((long)b * SEQ + (long)k0 * dil + rho) * 1536 + gh * 64;
    f32x16 o[2]; float m_reg, l_reg;
    attn_body<4, true>(Qb, ld, Kb, ld, Vb, ld, 6, LOG2E, 8.f, k0 - p0, o, m_reg, l_reg);
#pragma unroll
    for (int r = 0; r < 16; ++r) {
      const long tok = (long)b * SEQ + (long)(p0 + wid * 32 + crow(r, hi)) * dil + rho;
#pragma unroll
      for (int d0 = 0; d0 < 2; ++d0) OG[tok * 1536 + gh * 64 + d0 * 32 + r32] = (bf16_t)(cvtpk(o[d0][r], 0.f) & 0xffffu);
    }
    if (hi == 0) { const long tok = (long)b * SEQ + (long)(p0 + wid * 32 + r32) * dil + rho; LSE[tok * 24 + gh] = m_reg + __logf(l_reg); }
    __syncthreads();
  }
}

__device__ void phase_combine(const Params& P) {
  unsigned char* ws = P.ws;
  const bf16_t* OG = (const bf16_t*)(ws + WS_OG); const float* LSE = (const float*)(ws + WS_LSE); const bf16_t* ZD = (const bf16_t*)(ws + WS_ZD);
  bf16_t* A2 = (bf16_t*)(ws + WS_A2);
  const long gtid = (long)blockIdx.x * NTHREADS + otid(), gsz = (long)gridDim.x * NTHREADS;
  for (long it = gtid; it < (long)NTOK * 64; it += gsz) {
    const long tok = it >> 6; const int c8 = (int)(it & 63), hh = c8 >> 3, col = c8 * 8;
    const float l0 = LSE[tok * 24 + hh], l1 = LSE[tok * 24 + 8 + hh], l2 = LSE[tok * 24 + 16 + hh];
    const float mx = fmaxf(l0, fmaxf(l1, l2));
    float w0 = __expf(l0 - mx), w1 = __expf(l1 - mx), w2 = __expf(l2 - mx);
    const float inv = 1.f / (w0 + w1 + w2); w0 *= inv; w1 *= inv; w2 *= inv;
    const u32x4 a = *(const u32x4*)(OG + tok * 1536 + col), bq = *(const u32x4*)(OG + tok * 1536 + 512 + col), c = *(const u32x4*)(OG + tok * 1536 + 1024 + col);
    const u32x4 z = *(const u32x4*)(ZD + tok * 512 + col);
    u32x4 r;
#pragma unroll
    for (int e = 0; e < 4; ++e) {
      const float lo = (w0 * bflo(a[e]) + w1 * bflo(bq[e]) + w2 * bflo(c[e])) * bflo(z[e]);
      const float hi_ = (w0 * bfhi(a[e]) + w1 * bfhi(bq[e]) + w2 * bfhi(c[e])) * bfhi(z[e]);
      r[e] = cvtpk(lo, hi_);
    }
    *(u32x4*)(A2 + tok * 512 + col) = r;
  }
}

__device__ void phase_kpe(const Params& P) {
  unsigned char* ws = P.ws;
  const bf16_t* CKVR = (const bf16_t*)(ws + WS_CKVR); bf16_t* MK = (bf16_t*)(ws + WS_MK);
  const float* cosT = (const float*)(ws + WS_COS); const float* sinT = (const float*)(ws + WS_SIN);
  const long gtid = (long)blockIdx.x * NTHREADS + otid(), gsz = (long)gridDim.x * NTHREADS;
  for (long it = gtid; it < (long)NTOK * 16; it += gsz) {
    const long tok = it >> 4; const int i = (int)(it & 15);
    const float a = bf2f(CKVR[tok * 256 + 128 + i]), bb = bf2f(CKVR[tok * 256 + 144 + i]);
    const float c = cosT[tok * 32 + 2 * i], s = sinT[tok * 32 + 2 * i];
    const bf16_t o1 = (bf16_t)(cvtpk(a * c - bb * s, 0.f) & 0xffffu), o2 = (bf16_t)(cvtpk(bb * c + a * s, 0.f) & 0xffffu);
    const long b = tok / SEQ, s_ = tok % SEQ;
#pragma unroll
    for (int h = 0; h < 8; ++h) { bf16_t* kr = MK + ((b * 8 + h) * SEQ + s_) * 96 + 64; kr[i] = o1; kr[16 + i] = o2; }
  }
}

__device__ void phase_mla(const Params& P) {
  unsigned char* ws = P.ws;
  const bf16_t* MQ = (const bf16_t*)(ws + WS_MQ); const bf16_t* MK = (const bf16_t*)(ws + WS_MK); const bf16_t* MV = (const bf16_t*)(ws + WS_MV);
  const bf16_t* ZM = (const bf16_t*)(ws + WS_ZM); bf16_t* A1 = (bf16_t*)(ws + WS_A1);
  const int tid = otid(), wid = tid >> 6, lane = tid & 63, r32 = lane & 31, hi = lane >> 5;
  const float scale = 0.10206207261596577f;
  const int G = gridDim.x;
  for (int u0 = blockIdx.x; u0 < 1024; u0 += G) {
    int u = u0;
    if (G == 256) { const int i = u0 >> 8, bx = u0 & 255; u = (i * 8 + (bx & 7)) * 32 + (bx >> 3); }
    const int bh = u >> 5, qb = u & 31, b = bh >> 3, h = bh & 7;
    const bf16_t* Qb = MQ + ((long)bh * SEQ + qb * 256) * 96;
    f32x16 o[2]; float m_reg, l_reg;
    attn_body<6, false>(Qb, 96, MK + (long)bh * SEQ * 96, 96, MV + (long)bh * SEQ * 64, 64, SEQ / 64, scale * LOG2E, 8.f / scale, 0, o, m_reg, l_reg);
#pragma unroll
    for (int r = 0; r < 16; ++r) {
      const long tok = (long)b * SEQ + qb * 256 + wid * 32 + crow(r, hi);
#pragma unroll
      for (int d0 = 0; d0 < 2; ++d0) {
        const long idx = tok * 512 + h * 64 + d0 * 32 + r32;
        A1[idx] = (bf16_t)(cvtpk(o[d0][r] * bf2f(ZM[idx]), 0.f) & 0xffffu);
      }
    }
    __syncthreads();
  }
}

__device__ void phase_final_norm(const Params& P) {
  const long gtid = (long)blockIdx.x * NTHREADS + otid(), gsz = (long)gridDim.x * NTHREADS;
  const int lane = otid() & 63; const long wv = gtid >> 6, nwv = gsz >> 6;
  f32x4 g4[4];
#pragma unroll
  for (int c = 0; c < 4; ++c) g4[c] = *(const f32x4*)(P.final_g + c * 256 + lane * 4);
  for (long row = wv; row < NTOK; row += nwv) {
    float* xr = P.out + row * DM; f32x4 v[4]; float ss = 0.f;
#pragma unroll
    for (int c = 0; c < 4; ++c) { v[c] = *(const f32x4*)(xr + c * 256 + lane * 4); ss += v[c][0] * v[c][0] + v[c][1] * v[c][1] + v[c][2] * v[c][2] + v[c][3] * v[c][3]; }
    ss = wave_sum(ss);
    const float rs = rsqrtf(ss * (1.f / DM) + RMS_EPS);
#pragma unroll
    for (int c = 0; c < 4; ++c) *(f32x4*)(xr + c * 256 + lane * 4) = v[c] * rs * g4[c];
  }
}

constexpr int N_PHASES = 11;
template <int PH>
__device__ __forceinline__ void run_phase(const Params& P) {
  unsigned char* ws = P.ws;
  const bf16_t* H = (const bf16_t*)P.out;
  if constexpr (PH == 0) phase_prep(P);
  else if constexpr (PH == 1) phase_gemm<M_IN>(P, H, (const bf16_t*)(ws + WS_WIN), 1024, 12, 20, 12);
  else if constexpr (PH == 2) phase_dilated(P);
  else if constexpr (PH == 3) phase_combine(P);
  else if constexpr (PH == 4) phase_gemm<M_IN>(P, H, (const bf16_t*)(ws + WS_WIN), 1024, 0, 12, 0);
  else if constexpr (PH == 5) {
    phase_gemm<M_UQ>(P, (const bf16_t*)(ws + WS_CQ), (const bf16_t*)(ws + WS_WUQ), 256, 0, 4, 0);
    phase_gemm<M_UKV>(P, (const bf16_t*)(ws + WS_CKVR), (const bf16_t*)(ws + WS_WUKV), 256, 0, 4, 0);
    phase_kpe(P);
  }
  else if constexpr (PH == 6) phase_mla(P);
  else if constexpr (PH == 7) phase_gemm<M_OUT1>(P, (const bf16_t*)(ws + WS_A1), (const bf16_t*)(ws + WS_WOM), 512, 0, 4, 0);
  else if constexpr (PH == 8) phase_gemm<M_OUT2>(P, (const bf16_t*)(ws + WS_A2), (const bf16_t*)(ws + WS_WOD), 512, 0, 4, 0);
  else if constexpr (PH == 9) phase_gemm<M_FINAL>(P, (const bf16_t*)(ws + WS_MERGED), (const bf16_t*)(ws + WS_WOUT), 1024, 0, 4, 0);
  else phase_final_norm(P);
}

#if N_LAUNCH_PER_PHASE
template <int PH>
__global__ void __launch_bounds__(NTHREADS) k_phase(Params P) { run_phase<PH>(P); }
#else
__global__ void __launch_bounds__(NTHREADS) k_mega(Params P) {
  cg::grid_group grid = cg::this_grid();
  run_phase<0>(P); grid.sync();
  run_phase<1>(P); grid.sync();
  run_phase<2>(P); grid.sync();
  run_phase<3>(P); grid.sync();
  run_phase<4>(P); grid.sync();
  run_phase<5>(P); grid.sync();
  run_phase<6>(P); grid.sync();
  run_phase<7>(P); grid.sync();
  run_phase<8>(P); grid.sync();
  run_phase<9>(P); grid.sync();
  run_phase<10>(P);
}
#endif

template <int PH> static void launch_phase(const Params& p, int grid, hipStream_t stream) {
#if N_LAUNCH_PER_PHASE
  static bool attr = false;
  if (!attr) { (void)hipFuncSetAttribute((const void*)k_phase<PH>, hipFuncAttributeMaxDynamicSharedMemorySize, LDS_BYTES); attr = true; }
  hipLaunchKernelGGL(k_phase<PH>, dim3(grid), dim3(NTHREADS), LDS_BYTES, stream, p);
#endif
}

extern "C" void kernel_launch(void* const* d_in, const int* in_sizes, int n_in, void* d_out, int out_size, void* d_ws, size_t ws_size, hipStream_t stream) {
  static int grid = 0;
  if (grid == 0) {
    if (n_in != 13 || in_sizes[0] != NTOK * DM || out_size != NTOK * DM || ws_size < WS_END) {
      fprintf(stderr, "kernel_launch: unexpected shapes (n_in %d, in0 %d, out %d, ws %zu)\n", n_in, n_in > 0 ? in_sizes[0] : -1, out_size, ws_size); grid = -1; return; }
    int dev = 0, cus = 0;
    (void)hipGetDevice(&dev); (void)hipDeviceGetAttribute(&cus, hipDeviceAttributeMultiprocessorCount, dev);
#if N_LAUNCH_PER_PHASE
    grid = cus > 0 ? cus : 256;
#else
    int per_cu = 0;
    if (hipFuncSetAttribute((const void*)k_mega, hipFuncAttributeMaxDynamicSharedMemorySize, LDS_BYTES) != hipSuccess) { fprintf(stderr, "kernel_launch: hipFuncSetAttribute failed\n"); grid = -1; return; }
    if (hipOccupancyMaxActiveBlocksPerMultiprocessor(&per_cu, (const void*)k_mega, NTHREADS, LDS_BYTES) != hipSuccess || per_cu < 1) { fprintf(stderr, "kernel_launch: occupancy query failed (%d)\n", per_cu); grid = -1; return; }
    grid = cus;
#endif
  }
  if (grid < 0) return;
  Params p{};
  p.x = (const float*)d_in[0]; p.pos = (const int*)d_in[1]; p.attn_g = (const float*)d_in[2]; p.w_in = (const float*)d_in[3]; p.b_gate = (const float*)d_in[4];
  p.gq = (const float*)d_in[5]; p.gkv = (const float*)d_in[6]; p.w_uq = (const float*)d_in[7]; p.w_ukv = (const float*)d_in[8]; p.w_om = (const float*)d_in[9];
  p.w_od = (const float*)d_in[10]; p.w_out = (const float*)d_in[11]; p.final_g = (const float*)d_in[12];
  p.out = (float*)d_out; p.ws = (unsigned char*)d_ws;
  for (int i = 0; i < 32; ++i) p.inv_freq[i] = powf(10000.0f, -(float)(2 * i) / 64.0f);
#if N_LAUNCH_PER_PHASE
  launch_phase<0>(p, grid, stream); launch_phase<1>(p, grid, stream); launch_phase<2>(p, grid, stream); launch_phase<3>(p, grid, stream);
  launch_phase<4>(p, grid, stream); launch_phase<5>(p, grid, stream); launch_phase<6>(p, grid, stream); launch_phase<7>(p, grid, stream);
  launch_phase<8>(p, grid, stream); launch_phase<9>(p, grid, stream); launch_phase<10>(p, grid, stream);
#else
  void* args[] = {&p};
  hipError_t e = hipLaunchCooperativeKernel((const void*)k_mega, dim3(grid), dim3(NTHREADS), args, LDS_BYTES, stream);
  if (e != hipSuccess) fprintf(stderr, "cooperative launch failed: %s (grid %d)\n", hipGetErrorString(e), grid);
#endif
}
```

```cpp
#include <hip/hip_runtime.h>
#include <hip/hip_cooperative_groups.h>
#include <cstdio>
#include <cstdint>
#include <cmath>
namespace cg = cooperative_groups;

#ifndef N_LAUNCH_PER_PHASE
#define N_LAUNCH_PER_PHASE 0
#endif

#define LAS __attribute__((address_space(3)))
typedef unsigned short bf16_t;
using bf16x8 = __attribute__((ext_vector_type(8))) short;
using s16x4  = __attribute__((ext_vector_type(4))) short;
using f32x4  = __attribute__((ext_vector_type(4))) float;
using f32x16 = __attribute__((ext_vector_type(16))) float;
using u32x4  = __attribute__((ext_vector_type(4))) unsigned;
using u32x2  = __attribute__((ext_vector_type(2))) unsigned;

constexpr int SEQ = 8192, NBATCH = 4, DM = 1024, NTOK = NBATCH * SEQ, INW = 8096;
constexpr int NTHREADS = 512;
constexpr float RMS_EPS = 1e-6f;
constexpr float LOG2E = 1.4426950408889634f;
constexpr size_t MiB = 1ull << 20;
constexpr size_t WS_WIN = 0, WS_WUQ = 16 * MiB, WS_WUKV = WS_WUQ + MiB / 2, WS_WOM = 17 * MiB, WS_WOD = 18 * MiB, WS_WOUT = 19 * MiB,
                 WS_LSE = 21 * MiB, WS_COS = 24 * MiB, WS_SIN = 28 * MiB, WS_ZD = 32 * MiB, WS_A2 = 64 * MiB, WS_A1 = 96 * MiB,
                 WS_QD = 128 * MiB, WS_KD = 224 * MiB, WS_VD = 320 * MiB, WS_OG = 416 * MiB, WS_END = 512 * MiB,
                 WS_CQ = 128 * MiB, WS_CKVR = 144 * MiB, WS_ZM = 160 * MiB, WS_MQ = 192 * MiB, WS_MK = 240 * MiB, WS_MV = 288 * MiB,
                 WS_GM = 320 * MiB, WS_GD = 384 * MiB, WS_MERGED = 128 * MiB, WS_PRE = 192 * MiB;
constexpr size_t OUT_BAR_OFF = 64 * MiB;
constexpr int LDS_BYTES = 131072 + 2048;
constexpr int LDS_MISC = 131072;

struct Params {
  const float* x; const int* pos; const float* attn_g; const float* w_in; const float* b_gate; const float* gq; const float* gkv;
  const float* w_uq; const float* w_ukv; const float* w_om; const float* w_od; const float* w_out; const float* final_g;
  float* out; unsigned char* ws;
  float inv_freq[32];
};

extern __shared__ __attribute__((aligned(16))) unsigned char smem[];

__device__ __forceinline__ unsigned cvtpk(float lo, float hi) {
  unsigned r; asm volatile("v_cvt_pk_bf16_f32 %0, %1, %2" : "=v"(r) : "v"(lo), "v"(hi)); return r;
}
__device__ __forceinline__ float bf2f(unsigned short v) { return __uint_as_float(((unsigned)v) << 16); }
__device__ __forceinline__ float bflo(unsigned w) { return __uint_as_float(w << 16); }
__device__ __forceinline__ float bfhi(unsigned w) { return __uint_as_float(w & 0xffff0000u); }
__device__ __forceinline__ float sigmoidf_(float v) { return 1.f / (1.f + __expf(-v)); }
__device__ __forceinline__ float wave_sum(float v) {
#pragma unroll
  for (int o = 32; o > 0; o >>= 1) v += __shfl_xor(v, o);
  return v;
}
__device__ __forceinline__ int otid() { int t = threadIdx.x; asm volatile("" : "+v"(t)); return t; }
__device__ __forceinline__ int vcu_id() { const int bx = blockIdx.x, G = gridDim.x; return (G % 8 == 0) ? (bx % 8) * (G / 8) + bx / 8 : bx; }

constexpr int BK = 64, HTB = 128 * BK * 2;
__device__ __forceinline__ int lds_byte(int r, int c) {
  int st = (r >> 4) * 2 + (c >> 5), rr = r & 15, cc = c & 31, ob = rr * 64 + cc * 2;
  return st * 1024 + (ob ^ (((ob >> 9) & 1) << 5));
}
__device__ __forceinline__ void stage_rc(int b, int& R, int& C) {
  int st = b / 1024, sb = b % 1024, swz = sb ^ (((sb >> 9) & 1) << 5);
  R = (st >> 1) * 16 + swz / 64; C = (st & 1) * 32 + (swz % 64) / 2;
}

enum { M_IN = 0, M_UQ = 1, M_UKV = 2, M_OUT1 = 3, M_OUT2 = 4, M_FINAL = 5 };

__device__ __forceinline__ void st4bf(bf16_t* p, f32x4 v) { u32x2 w; w.x = cvtpk(v[0], v[1]); w.y = cvtpk(v[2], v[3]); *(u32x2*)p = w; }

template <int TYPE>
__device__ __forceinline__ void epi_in(const Params& P, const f32x4 (&acc)[2][2][4][2], bf16_t* dst, const int ld, const int col0, const float* bias, const float qs,
                                       const int row0, const int wc, const int fq) {
  const float* cosT = (const float*)(P.ws + WS_COS); const float* sinT = (const float*)(P.ws + WS_SIN);
  const int fi = (wc & 1) * 16 + fq * 4;
#pragma unroll
  for (int ai = 0; ai < 2; ++ai)
#pragma unroll
    for (int m = 0; m < 4; ++m) {
      const int row = row0 + ai * 128 + m * 16;
      f32x4 cs = {1.f, 1.f, 1.f, 1.f}, sn = {0.f, 0.f, 0.f, 0.f};
      if constexpr (TYPE == 3) { cs = *(const f32x4*)(cosT + (size_t)row * 32 + fi); sn = *(const f32x4*)(sinT + (size_t)row * 32 + fi); }
#pragma unroll
      for (int bj = 0; bj < 2; ++bj) {
        const int lc = (bj * 2 + (wc >> 1)) * 64 + fi;
        f32x4 v0 = acc[ai][bj][m][0], v1 = acc[ai][bj][m][1];
        if constexpr (TYPE == 1) {
#pragma unroll
          for (int j = 0; j < 4; ++j) { v0[j] = v0[j] * sigmoidf_(v0[j]); v1[j] = v1[j] * sigmoidf_(v1[j]); }
        } else if constexpr (TYPE == 2) {
          const f32x4 b0 = *(const f32x4*)(bias + lc), b1 = *(const f32x4*)(bias + lc + 32);
#pragma unroll
          for (int j = 0; j < 4; ++j) { v0[j] = sigmoidf_(v0[j] + b0[j]); v1[j] = sigmoidf_(v1[j] + b1[j]); }
        } else if constexpr (TYPE == 3) {
#pragma unroll
          for (int j = 0; j < 4; ++j) { const float a = v0[j], b = v1[j]; v0[j] = (a * cs[j] - b * sn[j]) * qs; v1[j] = (b * cs[j] + a * sn[j]) * qs; }
        }
        bf16_t* o = dst + (size_t)row * ld + col0 + lc;
        st4bf(o, v0); st4bf(o + 32, v1);
      }
    }
}

template <int MODE>
__device__ __forceinline__ void gemm_epilogue(const Params& P, const f32x4 (&acc)[2][2][4][2], const int pm, const int pn, const int wr, const int wc, const int fr, const int fq) {
  unsigned char* ws = P.ws;
  const int row0 = pm * 256 + wr * 64 + fr;
  if constexpr (MODE == M_IN) {
    if (pn == 0)      epi_in<0>(P, acc, (bf16_t*)(ws + WS_CQ),   256,  0,               nullptr, 1.f, row0, wc, fq);
    else if (pn == 1) epi_in<0>(P, acc, (bf16_t*)(ws + WS_CKVR), 256,  0,               nullptr, 1.f, row0, wc, fq);
    else if (pn < 4)  epi_in<1>(P, acc, (bf16_t*)(ws + WS_ZM),   512,  (pn - 2) * 256,  nullptr, 1.f, row0, wc, fq);
    else if (pn < 8)  epi_in<2>(P, acc, (bf16_t*)(ws + WS_GM),   1024, (pn - 4) * 256,  P.b_gate + (pn - 4) * 256, 1.f, row0, wc, fq);
    else if (pn < 12) epi_in<2>(P, acc, (bf16_t*)(ws + WS_GD),   1024, (pn - 8) * 256,  P.b_gate + 1024 + (pn - 8) * 256, 1.f, row0, wc, fq);
    else if (pn < 18) epi_in<3>(P, acc, (bf16_t*)(ws + WS_QD),   1536, (pn - 12) * 256, nullptr, 0.125f, row0, wc, fq);
    else if (pn < 24) epi_in<3>(P, acc, (bf16_t*)(ws + WS_KD),   1536, (pn - 18) * 256, nullptr, 1.f, row0, wc, fq);
    else if (pn < 30) epi_in<0>(P, acc, (bf16_t*)(ws + WS_VD),   1536, (pn - 24) * 256, nullptr, 1.f, row0, wc, fq);
    else              epi_in<1>(P, acc, (bf16_t*)(ws + WS_ZD),   512,  (pn - 30) * 256, nullptr, 1.f, row0, wc, fq);
  } else if constexpr (MODE == M_UQ || MODE == M_UKV) {
    const LAS float* rstd = (const LAS float*)((LAS unsigned char*)smem + LDS_MISC);
    const float* cosT = (const float*)(ws + WS_COS); const float* sinT = (const float*)(ws + WS_SIN);
    bf16_t* MQ = (bf16_t*)(ws + WS_MQ); bf16_t* MK = (bf16_t*)(ws + WS_MK); bf16_t* MV = (bf16_t*)(ws + WS_MV);
#pragma unroll
    for (int ai = 0; ai < 2; ++ai)
#pragma unroll
      for (int m = 0; m < 4; ++m) {
        const int lr = ai * 128 + wr * 64 + m * 16 + fr;
        const int row = pm * 256 + lr;
        const int b = row / SEQ, s = row % SEQ;
        const float rs = rstd[lr];
#pragma unroll
        for (int bj = 0; bj < 2; ++bj) {
          const int head = 2 * pn + bj;
          f32x4 v0 = acc[ai][bj][m][0] * rs, v1 = acc[ai][bj][m][1] * rs;
          const size_t hrow = (size_t)(b * 8 + head) * SEQ + s;
          if constexpr (MODE == M_UQ) {
            if (wc < 2) { bf16_t* o = MQ + hrow * 96 + wc * 32 + fq * 4; st4bf(o, v0); st4bf(o + 16, v1); }
            else if (wc == 2) {
#pragma unroll
              for (int j = 0; j < 4; ++j) {
                const float c = cosT[(size_t)row * 32 + 2 * (fq * 4 + j)], sn = sinT[(size_t)row * 32 + 2 * (fq * 4 + j)];
                const float a = v0[j], bb = v1[j]; v0[j] = a * c - bb * sn; v1[j] = bb * c + a * sn;
              }
              bf16_t* o = MQ + hrow * 96 + 64 + fq * 4; st4bf(o, v0); st4bf(o + 16, v1);
            }
          } else {
            if (wc < 2) { bf16_t* o = MK + hrow * 96 + wc * 32 + fq * 4; st4bf(o, v0); st4bf(o + 16, v1); }
            else        { bf16_t* o = MV + hrow * 64 + (wc - 2) * 32 + fq * 4; st4bf(o, v0); st4bf(o + 16, v1); }
          }
        }
      }
  } else if constexpr (MODE == M_OUT1 || MODE == M_OUT2) {
    const bf16_t* G = (const bf16_t*)(ws + (MODE == M_OUT1 ? WS_GM : WS_GD));
    bf16_t* Mg = (bf16_t*)(ws + WS_MERGED);
#pragma unroll
    for (int ai = 0; ai < 2; ++ai)
#pragma unroll
      for (int m = 0; m < 4; ++m) {
        const int row = row0 + ai * 128 + m * 16;
#pragma unroll
        for (int bj = 0; bj < 2; ++bj)
#pragma unroll
          for (int n = 0; n < 2; ++n) {
            const size_t idx = (size_t)row * 1024 + pn * 256 + bj * 128 + wc * 32 + n * 16 + fq * 4;
            const u32x2 g = *(const u32x2*)(G + idx);
            f32x4 v = acc[ai][bj][m][n];
            v[0] *= bflo(g.x); v[1] *= bfhi(g.x); v[2] *= bflo(g.y); v[3] *= bfhi(g.y);
            if constexpr (MODE == M_OUT2) { const u32x2 t = *(const u32x2*)(Mg + idx); v[0] += bflo(t.x); v[1] += bfhi(t.x); v[2] += bflo(t.y); v[3] += bfhi(t.y); }
            st4bf(Mg + idx, v);
          }
      }
  } else {
#pragma unroll
    for (int ai = 0; ai < 2; ++ai)
#pragma unroll
      for (int m = 0; m < 4; ++m) {
        const int row = row0 + ai * 128 + m * 16;
#pragma unroll
        for (int bj = 0; bj < 2; ++bj)
#pragma unroll
          for (int n = 0; n < 2; ++n) {
            const size_t idx = (size_t)row * 1024 + pn * 256 + bj * 128 + wc * 32 + n * 16 + fq * 4;
            const f32x4 xv = *(const f32x4*)(P.x + idx);
            *(f32x4*)((float*)(ws + WS_PRE) + idx) = acc[ai][bj][m][n] + xv;
          }
      }
  }
}

template <int MODE>
__device__ __forceinline__ void gemm_tile(const Params& P, const bf16_t* __restrict__ A, const bf16_t* __restrict__ Bt, const int K, const int pm, const int pnb, const int pn_epi) {
  LAS unsigned char* lds = (LAS unsigned char*)smem;
  const int tid = otid(), wid = __builtin_amdgcn_readfirstlane(tid >> 6), lane = tid & 63, wr = wid >> 2, wc = wid & 3, fr = lane & 15, fq = lane >> 4;
  const int brow = pm * 256, bcol = pnb * 256;
  __syncthreads();
  if constexpr (MODE == M_UQ || MODE == M_UKV) {
    constexpr int NC = (MODE == M_UQ) ? 256 : 128;
    const int r = tid >> 1, hf = tid & 1;
    const bf16_t* ap = A + (size_t)(brow + r) * K + hf * (NC / 2);
    float ss = 0.f;
#pragma unroll
    for (int i = 0; i < NC / 16; ++i) {
      const u32x4 w = *(const u32x4*)(ap + i * 8);
#pragma unroll
      for (int e = 0; e < 4; ++e) { const float a = bflo(w[e]), b = bfhi(w[e]); ss += a * a + b * b; }
    }
    ss += __shfl_xor(ss, 1);
    if (hf == 0) ((LAS float*)(lds + LDS_MISC))[r] = rsqrtf(ss * (1.f / NC) + RMS_EPS);
  }
  unsigned goff[2];
  { int R, C; stage_rc(tid * 16, R, C); goff[0] = (unsigned)(R * K + C) * 2u; goff[1] = goff[0] + (unsigned)(64 * K) * 2u; }
#define SAO(b, h) (((b) * 2 + (h)) * HTB)
#define SBO(b, h) ((4 + (b) * 2 + (h)) * HTB)
#define STAGE(PO, BASE, br, kt) do { const char* _g = (const char*)((BASE) + (size_t)(br) * K + (size_t)(kt) * BK); \
    _Pragma("unroll") for (int _i = 0; _i < 2; ++_i) \
      __builtin_amdgcn_global_load_lds((const unsigned*)(_g + goff[_i]), (LAS unsigned*)(lds + (PO) + wid * 1024 + _i * 8192), 16, 0, 0); } while (0)
#define LDA(dst, b, h) _Pragma("unroll") for (int m = 0; m < 4; ++m) _Pragma("unroll") for (int k = 0; k < 2; ++k) \
    dst[m][k] = *(const LAS bf16x8*)(lds + SAO(b, h) + lds_byte(wr * 64 + m * 16 + fr, k * 32 + fq * 8))
#define LDB(dst, b, h) _Pragma("unroll") for (int n = 0; n < 2; ++n) _Pragma("unroll") for (int k = 0; k < 2; ++k) \
    dst[n][k] = *(const LAS bf16x8*)(lds + SBO(b, h) + lds_byte(wc * 32 + n * 16 + fr, k * 32 + fq * 8))
#define MMA(ai, bj, AT, BT) do { __builtin_amdgcn_s_setprio(1); \
    _Pragma("unroll") for (int m = 0; m < 4; ++m) _Pragma("unroll") for (int n = 0; n < 2; ++n) _Pragma("unroll") for (int k = 0; k < 2; ++k) \
      acc[ai][bj][m][n] = __builtin_amdgcn_mfma_f32_16x16x32_bf16(BT[n][k], AT[m][k], acc[ai][bj][m][n], 0, 0, 0); \
    __builtin_amdgcn_s_setprio(0); } while (0)
#define WAIT_V(n) asm volatile("s_waitcnt vmcnt(" #n ")" ::: "memory")
#define WAIT_L(n) asm volatile("s_waitcnt lgkmcnt(" #n ")" ::: "memory")
#define BAR __builtin_amdgcn_s_barrier()
#define SCHED __builtin_amdgcn_sched_barrier(0)
  f32x4 acc[2][2][4][2] = {};
  bf16x8 At[4][2], B0[2][2], B1[2][2];
  const int nt = K / BK;
  STAGE(SBO(0, 0), Bt, bcol, 0); STAGE(SAO(0, 0), A, brow, 0);
  STAGE(SBO(0, 1), Bt, bcol + 128, 0); STAGE(SAO(0, 1), A, brow + 128, 0);
  if (wr == 1) BAR;
  WAIT_V(4); BAR;
  STAGE(SBO(1, 0), Bt, bcol, 1); STAGE(SAO(1, 0), A, brow, 1); STAGE(SBO(1, 1), Bt, bcol + 128, 1);
  WAIT_V(6); BAR;
  for (int t = 0; t < nt - 2; t += 2) {
    LDB(B0, 0, 0); SCHED; LDA(At, 0, 0); STAGE(SAO(1, 1), A, brow + 128, t + 1);
    WAIT_L(8); BAR; WAIT_L(0); MMA(0, 0, At, B0); BAR; SCHED;
    LDB(B1, 0, 1); STAGE(SBO(0, 0), Bt, bcol, t + 2);
    BAR; WAIT_L(0); MMA(0, 1, At, B1); BAR;
    LDA(At, 0, 1); STAGE(SAO(0, 0), A, brow, t + 2);
    BAR; WAIT_L(0); MMA(1, 0, At, B0); BAR; SCHED;
    STAGE(SBO(0, 1), Bt, bcol + 128, t + 2);
    WAIT_V(6); BAR; MMA(1, 1, At, B1); BAR;
    LDB(B0, 1, 0); SCHED; LDA(At, 1, 0); STAGE(SAO(0, 1), A, brow + 128, t + 2);
    WAIT_L(8); BAR; WAIT_L(0); MMA(0, 0, At, B0); BAR; SCHED;
    LDB(B1, 1, 1); STAGE(SBO(1, 0), Bt, bcol, t + 3);
    BAR; WAIT_L(0); MMA(0, 1, At, B1); BAR;
    LDA(At, 1, 1); STAGE(SAO(1, 0), A, brow, t + 3);
    BAR; WAIT_L(0); MMA(1, 0, At, B0); BAR; SCHED;
    STAGE(SBO(1, 1), Bt, bcol + 128, t + 3);
    WAIT_V(6); BAR; MMA(1, 1, At, B1); BAR;
  }
  { LDB(B0, 0, 0); LDA(At, 0, 0); STAGE(SAO(1, 1), A, brow + 128, nt - 1);
    BAR; WAIT_L(0); MMA(0, 0, At, B0); BAR;
    LDB(B1, 0, 1); BAR; WAIT_L(0); MMA(0, 1, At, B1); BAR;
    LDA(At, 0, 1); WAIT_V(4); BAR; WAIT_L(0); MMA(1, 0, At, B0); MMA(1, 1, At, B1); BAR; }
  { LDB(B0, 1, 0); LDA(At, 1, 0); WAIT_V(2); BAR; WAIT_L(0); MMA(0, 0, At, B0); BAR;
    LDB(B1, 1, 1); WAIT_V(0); BAR; WAIT_L(0); MMA(0, 1, At, B1); BAR;
    LDA(At, 1, 1); BAR; WAIT_L(0); MMA(1, 0, At, B0); MMA(1, 1, At, B1); BAR; }
  if (wr == 0) BAR;
  { int l2 = lane; asm volatile("" : "+v"(l2));
    gemm_epilogue<MODE>(P, acc, pm, pn_epi, wr, wc, l2 & 15, l2 >> 4); }
#undef SAO
#undef SBO
#undef STAGE
#undef LDA
#undef LDB
#undef MMA
}

#define KSWZ(row, colB) ((row) * 256 + ((colB) ^ (((row) & 7) << 4)))
#define SBAR() __builtin_amdgcn_sched_barrier(0)
constexpr int AT_V = 64 * 64 * 2, AT_K = 64 * 256, AT_KOFF = 2 * AT_V, AT_WSOFF = 2 * AT_V + 2 * AT_K;
__device__ __forceinline__ int crow(int r, int hi) { return (r & 3) + 8 * (r >> 2) + 4 * hi; }
__device__ __forceinline__ int v_st(int k, int c) { const int kk = (k & ~0xC) | ((k & 4) << 1) | ((k & 8) >> 1); return ((kk >> 3) * 2 + (c >> 5)) * 512 + ((kk & 7) * 32 + (c & 31)) * 2; }
__device__ __forceinline__ int v_rd_base(int lane) { return ((lane & 3) << 3) | (((lane >> 2) & 3) << 6) | (((lane >> 4) & 1) << 5) | (((lane >> 5) & 1) << 8); }
constexpr int v_rd_off(int d0, int ks, int half) { return d0 * 512 + ks * 2048 + half * 1024; }
template <int OFF> __device__ __forceinline__ s16x4 tr_read(int vb) {
  s16x4 r; asm volatile("ds_read_b64_tr_b16 %0, %1 offset:%2" : "=&v"(r) : "v"(vb), "i"(OFF) : "memory"); return r;
}
template <int D0> __device__ __forceinline__ void pv_one(f32x16& od, int vb, bf16x8 pa0, bf16x8 pa1, bf16x8 pa2, bf16x8 pa3) {
  const s16x4 l0 = tr_read<v_rd_off(D0, 0, 0)>(vb), h0 = tr_read<v_rd_off(D0, 0, 1)>(vb), l1 = tr_read<v_rd_off(D0, 1, 0)>(vb), h1 = tr_read<v_rd_off(D0, 1, 1)>(vb);
  const s16x4 l2 = tr_read<v_rd_off(D0, 2, 0)>(vb), h2 = tr_read<v_rd_off(D0, 2, 1)>(vb), l3 = tr_read<v_rd_off(D0, 3, 0)>(vb), h3 = tr_read<v_rd_off(D0, 3, 1)>(vb);
  asm volatile("s_waitcnt lgkmcnt(0)" ::: "memory"); SBAR();
#define PK(L, H) (bf16x8){L[0], L[1], L[2], L[3], H[0], H[1], H[2], H[3]}
  od = __builtin_amdgcn_mfma_f32_32x32x16_bf16(pa0, PK(l0, h0), od, 0, 0, 0);
  od = __builtin_amdgcn_mfma_f32_32x32x16_bf16(pa1, PK(l1, h1), od, 0, 0, 0);
  od = __builtin_amdgcn_mfma_f32_32x32x16_bf16(pa2, PK(l2, h2), od, 0, 0, 0);
  od = __builtin_amdgcn_mfma_f32_32x32x16_bf16(pa3, PK(l3, h3), od, 0, 0, 0);
#undef PK
}
__device__ __forceinline__ void partialSM(f32x16& p0, f32x16& p1, float& m_reg, float& mn, float& alpha, const float C, const float thr_raw) {
  float pmax = p0[0];
#pragma unroll
  for (int r = 1; r < 16; ++r) pmax = fmaxf(pmax, p0[r]);
#pragma unroll
  for (int r = 0; r < 16; ++r) pmax = fmaxf(pmax, p1[r]);
  { auto rr = __builtin_amdgcn_permlane32_swap(__float_as_uint(pmax), __float_as_uint(pmax), false, false);
    pmax = fmaxf(__uint_as_float(rr[0]), __uint_as_float(rr[1])); }
  if (__builtin_expect(__all(pmax - m_reg <= thr_raw), 1)) { mn = m_reg; alpha = 1.f; }
  else { mn = fmaxf(m_reg, pmax); alpha = __builtin_amdgcn_exp2f((m_reg - mn) * C); m_reg = mn; }
  const float mnC = -mn * C;
#pragma unroll
  for (int r = 0; r < 16; ++r) p0[r] = fmaf(p0[r], C, mnC);
#pragma unroll
  for (int r = 0; r < 16; ++r) p1[r] = fmaf(p1[r], C, mnC);
#pragma unroll
  for (int r = 0; r < 16; ++r) p0[r] = __builtin_amdgcn_exp2f(p0[r]);
}
__device__ __forceinline__ void finishSM(f32x16& p0, f32x16& p1, float alpha, float& l_reg, bf16x8& pa0, bf16x8& pa1, bf16x8& pa2, bf16x8& pa3) {
#pragma unroll
  for (int r = 0; r < 16; ++r) p1[r] = __builtin_amdgcn_exp2f(p1[r]);
  float ps = 0;
#pragma unroll
  for (int r = 0; r < 16; ++r) ps += p0[r];
#pragma unroll
  for (int r = 0; r < 16; ++r) ps += p1[r];
  { auto rr = __builtin_amdgcn_permlane32_swap(__float_as_uint(ps), __float_as_uint(ps), false, false);
    ps = __uint_as_float(rr[0]) + __uint_as_float(rr[1]); }
  l_reg = l_reg * alpha + ps;
#define PK4(Pv, BASE, OUT) do { unsigned a0 = cvtpk(Pv[BASE + 0], Pv[BASE + 1]), a1 = cvtpk(Pv[BASE + 2], Pv[BASE + 3]);   \
    unsigned b0 = cvtpk(Pv[BASE + 4], Pv[BASE + 5]), b1 = cvtpk(Pv[BASE + 6], Pv[BASE + 7]);                              \
    auto r0 = __builtin_amdgcn_permlane32_swap(a0, b0, false, false); auto r1 = __builtin_amdgcn_permlane32_swap(a1, b1, false, false); \
    u32x4 w = {r0[0], r1[0], r0[1], r1[1]}; OUT = *reinterpret_cast<bf16x8*>(&w); } while (0)
  PK4(p0, 0, pa0); PK4(p0, 8, pa1); PK4(p1, 0, pa2); PK4(p1, 8, pa3);
#undef PK4
}

template <int NQ, bool MASK>
__device__ __forceinline__ void attn_body(const bf16_t* __restrict__ Qb, const long ldq, const bf16_t* __restrict__ Kh, const long ldk,
                                          const bf16_t* __restrict__ Vh, const long ldv, const int NT, const float C, const float thr_raw, const int mdelta,
                                          f32x16 (&o)[2], float& m_reg, float& l_reg) {
  LAS unsigned char* lds = (LAS unsigned char*)smem;
  const int tid = otid(), wid = __builtin_amdgcn_readfirstlane(tid >> 6), lane = tid & 63, r32 = lane & 31, hi = lane >> 5;
  LAS float* wsl = (LAS float*)(lds + AT_WSOFF) + wid * 64; LAS float* al_l = wsl + 32;
  m_reg = MASK ? -30000.f : -1e30f; l_reg = 0.f;
  o[0] = f32x16{}; o[1] = f32x16{};
  bf16x8 qr[NQ];
  const bf16_t* Qw = Qb + (long)(wid * 32 + r32) * ldq + hi * 8;
#pragma unroll
  for (int d0 = 0; d0 < NQ; ++d0) qr[d0] = *(const bf16x8*)(Qw + d0 * 16);
  int kr0, kc0, kr1 = 0, kc1 = 0;
  if constexpr (NQ == 6) { kr0 = tid / 12; kc0 = (tid % 12) * 8; const int c1 = 512 + (tid & 255); kr1 = c1 / 12; kc1 = (c1 % 12) * 8; }
  else { kr0 = tid >> 3; kc0 = (tid & 7) * 8; }
  const int vr = tid >> 3, vc = (tid & 7) * 8;
  const int kst0 = KSWZ(kr0, kc0 * 2), kst1 = KSWZ(kr1, kc1 * 2), vst = v_st(vr, vc);
  const int vb0 = (int)(unsigned)(uintptr_t)lds + v_rd_base(lane);
  struct { bf16x8 v, k0, k1; } sr_[2];
#define SLOAD(i, kk0) do { sr_[i].v = *(const bf16x8*)(Vh + (long)((kk0) + vr) * ldv + vc); sr_[i].k0 = *(const bf16x8*)(Kh + (long)((kk0) + kr0) * ldk + kc0); \
    if constexpr (NQ == 6) sr_[i].k1 = *(const bf16x8*)(Kh + (long)((kk0) + kr1) * ldk + kc1); } while (0)
#define SWRITE(b, i) do { *(LAS bf16x8*)(lds + (b) * AT_V + vst) = sr_[i].v; *(LAS bf16x8*)(lds + AT_KOFF + (b) * AT_K + kst0) = sr_[i].k0; \
    if constexpr (NQ == 6) *(LAS bf16x8*)(lds + AT_KOFF + (b) * AT_K + kst1) = sr_[i].k1; } while (0)
#define SWAIT() do { if constexpr (NQ == 6) asm volatile("s_waitcnt vmcnt(3)" ::: "memory"); else asm volatile("s_waitcnt vmcnt(2)" ::: "memory"); } while (0)
#define RESC(a) do { if (__any((a) < 1.f)) { if (hi == 0) al_l[r32] = (a); asm volatile("s_waitcnt lgkmcnt(0)" ::: "memory"); \
    _Pragma("unroll") for (int d = 0; d < 2; ++d) _Pragma("unroll") for (int r = 0; r < 16; ++r) o[d][r] *= al_l[crow(r, hi)]; } } while (0)
#define QKT(P0, P1, b, tile) do { P0 = f32x16{}; P1 = f32x16{}; \
    _Pragma("unroll") for (int d0 = 0; d0 < NQ; ++d0) { const int cb = (d0 * 16 + hi * 8) * 2; \
      const bf16x8 b0 = *(const LAS bf16x8*)(lds + AT_KOFF + (b) * AT_K + KSWZ(r32, cb)); \
      const bf16x8 b1 = *(const LAS bf16x8*)(lds + AT_KOFF + (b) * AT_K + KSWZ(32 + r32, cb)); \
      P0 = __builtin_amdgcn_mfma_f32_32x32x16_bf16(b0, qr[d0], P0, 0, 0, 0); \
      P1 = __builtin_amdgcn_mfma_f32_32x32x16_bf16(b1, qr[d0], P1, 0, 0, 0); } \
    if constexpr (MASK) { const int dl = mdelta + (tile) * 64 - (wid * 32 + r32) + 4 * hi; \
      _Pragma("unroll") for (int r = 0; r < 16; ++r) { const int dd = dl + (r & 3) + 8 * (r >> 2); \
        if ((unsigned)(dd + 64) > 128u) P0[r] = -1e30f; if ((unsigned)(dd + 96) > 128u) P1[r] = -1e30f; } } } while (0)
#define PV(b) do { pv_one<0>(o[0], vb0 + (b) * AT_V, pa0, pa1, pa2, pa3); pv_one<1>(o[1], vb0 + (b) * AT_V, pa0, pa1, pa2, pa3); } while (0)
  f32x16 pA0, pA1, pB0, pB1; float mnA, mnB, alA, alB; bf16x8 pa0, pa1, pa2, pa3;
  SLOAD(0, 0); asm volatile("s_waitcnt vmcnt(0)" ::: "memory"); SWRITE(0, 0); __syncthreads();
  QKT(pA0, pA1, 0, 0); partialSM(pA0, pA1, m_reg, mnA, alA, C, thr_raw);
  SLOAD(1, 64); if (2 < NT) SLOAD(0, 128);
  SWAIT(); SWRITE(1, 1); __syncthreads();
  for (int j = 1; j + 1 < NT; j += 2) {
    SBAR(); QKT(pB0, pB1, 1, j);
    finishSM(pA0, pA1, alA, l_reg, pa0, pa1, pa2, pa3); SBAR();
    SLOAD(1, (j + 2) * 64); SBAR();
    PV(0); partialSM(pB0, pB1, m_reg, mnB, alB, C, thr_raw);
    __syncthreads(); SWAIT(); SWRITE(0, 0);
    RESC(alB); __syncthreads();
    SBAR(); QKT(pA0, pA1, 0, j + 1);
    finishSM(pB0, pB1, alB, l_reg, pa0, pa1, pa2, pa3); SBAR();
    if (j + 3 < NT) SLOAD(0, (j + 3) * 64); SBAR();
    PV(1); partialSM(pA0, pA1, m_reg, mnA, alA, C, thr_raw);
    __syncthreads(); SWAIT(); SWRITE(1, 1);
    RESC(alA); __syncthreads();
  }
  SBAR(); QKT(pB0, pB1, 1, NT - 1);
  finishSM(pA0, pA1, alA, l_reg, pa0, pa1, pa2, pa3); SBAR();
  PV(0); partialSM(pB0, pB1, m_reg, mnB, alB, C, thr_raw);
  __syncthreads(); RESC(alB);
  finishSM(pB0, pB1, alB, l_reg, pa0, pa1, pa2, pa3); SBAR();
  PV(1);
  if (hi == 0) wsl[r32] = l_reg;
  asm volatile("s_waitcnt lgkmcnt(0)" ::: "memory");
#pragma unroll
  for (int r = 0; r < 16; ++r) { const float rl = __builtin_amdgcn_rcpf(wsl[crow(r, hi)]); o[0][r] *= rl; o[1][r] *= rl; }
#undef SLOAD
#undef SWRITE
#undef SWAIT
#undef RESC
#undef QKT
#undef PV
}

__device__ __forceinline__ int perm_in(int p) { const int g = p >> 5, n = (p >> 4) & 1, fq = (p >> 2) & 3, j = p & 3; return (g >> 1) * 64 + (g & 1) * 16 + n * 32 + fq * 4 + j; }
__device__ __forceinline__ void prep_store(bf16_t* dst, const float* W, const int ldw, const int sc, const int k0, const int kvalid, const float* g) {
  float v[8];
#pragma unroll
  for (int e = 0; e < 8; ++e) { const int k = k0 + e; float t = 0.f; if (sc >= 0 && k < kvalid) { t = W[(size_t)k * ldw + sc]; if (g) t *= g[k]; } v[e] = t; }
  u32x4 w = {cvtpk(v[0], v[1]), cvtpk(v[2], v[3]), cvtpk(v[4], v[5]), cvtpk(v[6], v[7])};
  *(u32x4*)dst = w;
}
__device__ void phase_prep(const Params& P) {
  unsigned char* ws = P.ws;
  const long gtid = (long)blockIdx.x * NTHREADS + otid(), gsz = (long)gridDim.x * NTHREADS;
  for (long it = gtid; it < 8192L * 128; it += gsz) {
    const int n = (int)(it % 8192), k8 = (int)(it / 8192);
    const int t = n >> 8, l = perm_in(n & 255);
    int sc;
    if (t == 0) sc = l;
    else if (t == 1) sc = (l < 128) ? 256 + l : (l < 160 ? 384 + (l - 128) : -1);
    else if (t < 4) sc = 416 + (t - 2) * 256 + l;
    else if (t < 8) sc = 6048 + (t - 4) * 256 + l;
    else if (t < 12) sc = 7072 + (t - 8) * 256 + l;
    else if (t < 18) sc = 928 + (t - 12) * 256 + l;
    else if (t < 24) sc = 2464 + (t - 18) * 256 + l;
    else if (t < 30) sc = 4000 + (t - 24) * 256 + l;
    else sc = 5536 + (t - 30) * 256 + l;
    prep_store((bf16_t*)(ws + WS_WIN) + (size_t)n * 1024 + k8 * 8, P.w_in, INW, sc, k8 * 8, 1024, nullptr);
  }
  for (long it = gtid; it < 1024L * 32; it += gsz) {
    const int n = (int)(it % 1024), k8 = (int)(it / 1024);
    const int t = n >> 8, p = n & 255, gi = p >> 5, nn = (p >> 4) & 1, fq = (p >> 2) & 3, j = p & 3;
    const int head = 2 * t + (gi >> 2), sub = gi & 3;
    int sc;
    if (sub < 2) sc = head * 96 + sub * 32 + nn * 16 + fq * 4 + j;
    else if (sub == 2) sc = head * 96 + 64 + nn * 16 + fq * 4 + j;
    else sc = -1;
    prep_store((bf16_t*)(ws + WS_WUQ) + (size_t)n * 256 + k8 * 8, P.w_uq, 768, sc, k8 * 8, 256, P.gq);
  }
  for (long it = gtid; it < 1024L * 32; it += gsz) {
    const int n = (int)(it % 1024), k8 = (int)(it / 1024);
    prep_store((bf16_t*)(ws + WS_WUKV) + (size_t)n * 256 + k8 * 8, P.w_ukv, 1024, n, k8 * 8, 128, P.gkv);
  }
  for (long it = gtid; it < 1024L * 64; it += gsz) {
    const int n = (int)(it % 1024), k8 = (int)(it / 1024);
    prep_store((bf16_t*)(ws + WS_WOM) + (size_t)n * 512 + k8 * 8, P.w_om, 1024, n, k8 * 8, 512, nullptr);
    prep_store((bf16_t*)(ws + WS_WOD) + (size_t)n * 512 + k8 * 8, P.w_od, 1024, n, k8 * 8, 512, nullptr);
  }
  for (long it = gtid; it < 1024L * 128; it += gsz) {
    const int n = (int)(it % 1024), k8 = (int)(it / 1024);
    prep_store((bf16_t*)(ws + WS_WOUT) + (size_t)n * 1024 + k8 * 8, P.w_out, 1024, n, k8 * 8, 1024, nullptr);
  }
  for (long it = gtid; it < (long)NTOK * 32; it += gsz) {
    const int tok = (int)(it >> 5), i = (int)(it & 31);
    const double ang = (double)P.pos[tok] * (double)P.inv_freq[i];
    double rev = ang * 0.15915494309189535; rev -= floor(rev);
    const float rf = (float)rev;
    ((float*)(ws + WS_COS))[it] = __builtin_amdgcn_cosf(rf);
    ((float*)(ws + WS_SIN))[it] = __builtin_amdgcn_sinf(rf);
  }
  {
    const int lane = otid() & 63; const long wv = gtid >> 6, nwv = gsz >> 6;
    bf16_t* H = (bf16_t*)P.out;
    f32x4 g4[4];
#pragma unroll
    for (int c = 0; c < 4; ++c) g4[c] = *(const f32x4*)(P.attn_g + c * 256 + lane * 4);
    for (long row = wv; row < NTOK; row += nwv) {
      const float* xr = P.x + row * DM; f32x4 v[4]; float ss = 0.f;
#pragma unroll
      for (int c = 0; c < 4; ++c) { v[c] = *(const f32x4*)(xr + c * 256 + lane * 4); ss += v[c][0] * v[c][0] + v[c][1] * v[c][1] + v[c][2] * v[c][2] + v[c][3] * v[c][3]; }
      ss = wave_sum(ss);
      const float rs = rsqrtf(ss * (1.f / DM) + RMS_EPS);
#pragma unroll
      for (int c = 0; c < 4; ++c) { f32x4 t = v[c] * rs * g4[c]; st4bf(H + row * DM + c * 256 + lane * 4, t); }
    }
  }
}

template <int MODE>
__device__ void phase_gemm(const Params& P, const bf16_t* A, const bf16_t* Bt, const int K, const int pn_lo, const int npn, const int pnb_lo) {
  const int nunits = (NTOK / 256) * npn;
  for (int u = vcu_id(); u < nunits; u += gridDim.x) {
    const int pm = u / npn, pl = u % npn;
    gemm_tile<MODE>(P, A, Bt, K, pm, pnb_lo + pl, pn_lo + pl);
  }
  __syncthreads();
}

__device__ void phase_dilated(const Params& P) {
  unsigned char* ws = P.ws;
  const bf16_t* QD = (const bf16_t*)(ws + WS_QD); const bf16_t* KD = (const bf16_t*)(ws + WS_KD); const bf16_t* VD = (const bf16_t*)(ws + WS_VD);
  bf16_t* OG = (bf16_t*)(ws + WS_OG); float* LSE = (float*)(ws + WS_LSE);
  const int tid = otid(), wid = tid >> 6, lane = tid & 63, r32 = lane & 31, hi = lane >> 5;
  for (int u = vcu_id(); u < 3072; u += gridDim.x) {
    const int g = u >> 10, rem = u & 1023, b = rem >> 8, h8 = (rem >> 5) & 7, xx = rem & 31;
    const int dil = (g == 0) ? 1 : (g == 1 ? 4 : 16), L = SEQ / dil;
    const int rho = xx % dil, blk = xx / dil, gh = g * 8 + h8;
    const int p0 = blk * 256;
    int t0 = p0 / 64 - 1; t0 = t0 < 0 ? 0 : t0; if (t0 > L / 64 - 6) t0 = L / 64 - 6;
    const int k0 = t0 * 64;
    const long ld = (long)dil * 1536;
    const bf16_t* Qb = QD + ((long)b * SEQ + (long)p0 * dil + rho) * 1536 + gh * 64;
    const bf16_t* Kb = KD + ((long)b * SEQ + (long)k0 * dil + rho) * 1536 + gh * 64;
    const bf16_t* Vb = VD + ((long)b * SEQ + (long)k0 * dil + rho) * 1536 + gh * 64;
    f32x16 o[2]; float m_reg, l_reg;
    attn_body<4, true>(Qb, ld, Kb, ld, Vb, ld, 6, LOG2E, 8.f, k0 - p0, o, m_reg, l_reg);
#pragma unroll
    for (int r = 0; r < 16; ++r) {
      const long tok = (long)b * SEQ + (long)(p0 + wid * 32 + crow(r, hi)) * dil + rho;
#pragma unroll
      for (int d0 = 0; d0 < 2; ++d0) OG[tok * 1536 + gh * 64 + d0 * 32 + r32] = (bf16_t)(cvtpk(o[d0][r], 0.f) & 0xffffu);
    }
    if (hi == 0) { const long tok = (long)b * SEQ + (long)(p0 + wid * 32 + r32) * dil + rho; LSE[tok * 24 + gh] = m_reg + __logf(l_reg); }
    __syncthreads();
  }
}

__device__ void phase_combine(const Params& P) {
  unsigned char* ws = P.ws;
  const bf16_t* OG = (const bf16_t*)(ws + WS_OG); const float* LSE = (const float*)(ws + WS_LSE); const bf16_t* ZD = (const bf16_t*)(ws + WS_ZD);
  bf16_t* A2 = (bf16_t*)(ws + WS_A2);
  const long gtid = (long)blockIdx.x * NTHREADS + otid(), gsz = (long)gridDim.x * NTHREADS;
  for (long it = gtid; it < (long)NTOK * 64; it += gsz) {
    const long tok = it >> 6; const int c8 = (int)(it & 63), hh = c8 >> 3, col = c8 * 8;
    const float l0 = LSE[tok * 24 + hh], l1 = LSE[tok * 24 + 8 + hh], l2 = LSE[tok * 24 + 16 + hh];
    const float mx = fmaxf(l0, fmaxf(l1, l2));
    float w0 = __expf(l0 - mx), w1 = __expf(l1 - mx), w2 = __expf(l2 - mx);
    const float inv = 1.f / (w0 + w1 + w2); w0 *= inv; w1 *= inv; w2 *= inv;
    const u32x4 a = *(const u32x4*)(OG + tok * 1536 + col), bq = *(const u32x4*)(OG + tok * 1536 + 512 + col), c = *(const u32x4*)(OG + tok * 1536 + 1024 + col);
    const u32x4 z = *(const u32x4*)(ZD + tok * 512 + col);
    u32x4 r;
#pragma unroll
    for (int e = 0; e < 4; ++e) {
      const float lo = (w0 * bflo(a[e]) + w1 * bflo(bq[e]) + w2 * bflo(c[e])) * bflo(z[e]);
      const float hi_ = (w0 * bfhi(a[e]) + w1 * bfhi(bq[e]) + w2 * bfhi(c[e])) * bfhi(z[e]);
      r[e] = cvtpk(lo, hi_);
    }
    *(u32x4*)(A2 + tok * 512 + col) = r;
  }
}

__device__ void phase_kpe(const Params& P) {
  unsigned char* ws = P.ws;
  const bf16_t* CKVR = (const bf16_t*)(ws + WS_CKVR); bf16_t* MK = (bf16_t*)(ws + WS_MK);
  const float* cosT = (const float*)(ws + WS_COS); const float* sinT = (const float*)(ws + WS_SIN);
  const long gtid = (long)blockIdx.x * NTHREADS + otid(), gsz = (long)gridDim.x * NTHREADS;
  for (long it = gtid; it < (long)NTOK * 16; it += gsz) {
    const long tok = it >> 4; const int i = (int)(it & 15);
    const float a = bf2f(CKVR[tok * 256 + 128 + i]), bb = bf2f(CKVR[tok * 256 + 144 + i]);
    const float c = cosT[tok * 32 + 2 * i], s = sinT[tok * 32 + 2 * i];
    const bf16_t o1 = (bf16_t)(cvtpk(a * c - bb * s, 0.f) & 0xffffu), o2 = (bf16_t)(cvtpk(bb * c + a * s, 0.f) & 0xffffu);
    const long b = tok / SEQ, s_ = tok % SEQ;
#pragma unroll
    for (int h = 0; h < 8; ++h) { bf16_t* kr = MK + ((b * 8 + h) * SEQ + s_) * 96 + 64; kr[i] = o1; kr[16 + i] = o2; }
  }
}

__device__ void phase_mla(const Params& P) {
  unsigned char* ws = P.ws;
  const bf16_t* MQ = (const bf16_t*)(ws + WS_MQ); const bf16_t* MK = (const bf16_t*)(ws + WS_MK); const bf16_t* MV = (const bf16_t*)(ws + WS_MV);
  const bf16_t* ZM = (const bf16_t*)(ws + WS_ZM); bf16_t* A1 = (bf16_t*)(ws + WS_A1);
  const int tid = otid(), wid = tid >> 6, lane = tid & 63, r32 = lane & 31, hi = lane >> 5;
  const float scale = 0.10206207261596577f;
  const int G = gridDim.x;
  for (int u0 = blockIdx.x; u0 < 1024; u0 += G) {
    int u = u0;
    if (G == 256) { const int i = u0 >> 8, bx = u0 & 255; u = (i * 8 + (bx & 7)) * 32 + (bx >> 3); }
    const int bh = u >> 5, qb = u & 31, b = bh >> 3, h = bh & 7;
    const bf16_t* Qb = MQ + ((long)bh * SEQ + qb * 256) * 96;
    f32x16 o[2]; float m_reg, l_reg;
    attn_body<6, false>(Qb, 96, MK + (long)bh * SEQ * 96, 96, MV + (long)bh * SEQ * 64, 64, SEQ / 64, scale * LOG2E, 8.f / scale, 0, o, m_reg, l_reg);
#pragma unroll
    for (int r = 0; r < 16; ++r) {
      const long tok = (long)b * SEQ + qb * 256 + wid * 32 + crow(r, hi);
#pragma unroll
      for (int d0 = 0; d0 < 2; ++d0) {
        const long idx = tok * 512 + h * 64 + d0 * 32 + r32;
        A1[idx] = (bf16_t)(cvtpk(o[d0][r] * bf2f(ZM[idx]), 0.f) & 0xffffu);
      }
    }
    __syncthreads();
  }
}

__device__ void phase_final_norm(const Params& P) {
  const long gtid = (long)blockIdx.x * NTHREADS + otid(), gsz = (long)gridDim.x * NTHREADS;
  const int lane = otid() & 63; const long wv = gtid >> 6, nwv = gsz >> 6;
  f32x4 g4[4];
#pragma unroll
  for (int c = 0; c < 4; ++c) g4[c] = *(const f32x4*)(P.final_g + c * 256 + lane * 4);
  for (long row = wv; row < NTOK; row += nwv) {
    const float* xr = (const float*)(P.ws + WS_PRE) + row * DM; float* orow = P.out + row * DM; f32x4 v[4]; float ss = 0.f;
#pragma unroll
    for (int c = 0; c < 4; ++c) { v[c] = *(const f32x4*)(xr + c * 256 + lane * 4); ss += v[c][0] * v[c][0] + v[c][1] * v[c][1] + v[c][2] * v[c][2] + v[c][3] * v[c][3]; }
    ss = wave_sum(ss);
    const float rs = rsqrtf(ss * (1.f / DM) + RMS_EPS);
#pragma unroll
    for (int c = 0; c < 4; ++c) *(f32x4*)(orow + c * 256 + lane * 4) = v[c] * rs * g4[c];
  }
}

__device__ __forceinline__ void fast_barrier(unsigned* ctr, unsigned& epoch) {
  asm volatile("s_waitcnt vmcnt(0)" ::: "memory");
  __syncthreads();
  epoch += 1;
  if (threadIdx.x == 0) {
    __builtin_amdgcn_fence(__ATOMIC_RELEASE, "agent");
    asm volatile("s_waitcnt vmcnt(0)" ::: "memory");
    const unsigned target = epoch * gridDim.x;
    (void)__hip_atomic_fetch_add(ctr, 1u, __ATOMIC_RELAXED, __HIP_MEMORY_SCOPE_AGENT);
    while (__hip_atomic_load(ctr, __ATOMIC_RELAXED, __HIP_MEMORY_SCOPE_AGENT) < target) __builtin_amdgcn_s_sleep(1);
    __builtin_amdgcn_fence(__ATOMIC_ACQUIRE, "agent");
    asm volatile("s_waitcnt vmcnt(0)" ::: "memory");
  }
  __syncthreads();
}
constexpr int N_PHASES = 11;
template <int PH>
__device__ __forceinline__ void run_phase(const Params& P) {
  unsigned char* ws = P.ws;
  const bf16_t* H = (const bf16_t*)P.out;
  if constexpr (PH == 0) phase_prep(P);
  else if constexpr (PH == 1) phase_gemm<M_IN>(P, H, (const bf16_t*)(ws + WS_WIN), 1024, 12, 20, 12);
  else if constexpr (PH == 2) phase_dilated(P);
  else if constexpr (PH == 3) phase_combine(P);
  else if constexpr (PH == 4) phase_gemm<M_IN>(P, H, (const bf16_t*)(ws + WS_WIN), 1024, 0, 12, 0);
  else if constexpr (PH == 5) {
    phase_gemm<M_UQ>(P, (const bf16_t*)(ws + WS_CQ), (const bf16_t*)(ws + WS_WUQ), 256, 0, 4, 0);
    phase_gemm<M_UKV>(P, (const bf16_t*)(ws + WS_CKVR), (const bf16_t*)(ws + WS_WUKV), 256, 0, 4, 0);
    phase_kpe(P);
  }
  else if constexpr (PH == 6) phase_mla(P);
  else if constexpr (PH == 7) phase_gemm<M_OUT1>(P, (const bf16_t*)(ws + WS_A1), (const bf16_t*)(ws + WS_WOM), 512, 0, 4, 0);
  else if constexpr (PH == 8) phase_gemm<M_OUT2>(P, (const bf16_t*)(ws + WS_A2), (const bf16_t*)(ws + WS_WOD), 512, 0, 4, 0);
  else if constexpr (PH == 9) phase_gemm<M_FINAL>(P, (const bf16_t*)(ws + WS_MERGED), (const bf16_t*)(ws + WS_WOUT), 1024, 0, 4, 0);
  else phase_final_norm(P);
}

#if N_LAUNCH_PER_PHASE
template <int PH>
__global__ void __launch_bounds__(NTHREADS) k_phase(Params P) { run_phase<PH>(P); }
#else
__global__ void __launch_bounds__(NTHREADS) k_mega(Params P) {
  cg::grid_group grid = cg::this_grid();
  unsigned* ctr = (unsigned*)((unsigned char*)P.out + OUT_BAR_OFF); unsigned epoch = 0;
#define SEAM() fast_barrier(ctr, epoch)
  run_phase<0>(P); SEAM();
  run_phase<1>(P); SEAM();
  run_phase<2>(P); SEAM();
  run_phase<3>(P); SEAM();
  run_phase<4>(P); SEAM();
  run_phase<5>(P); SEAM();
  run_phase<6>(P); SEAM();
  run_phase<7>(P); SEAM();
  run_phase<8>(P); SEAM();
  run_phase<9>(P); grid.sync();
  run_phase<10>(P);
}
#endif

template <int PH> static void launch_phase(const Params& p, int grid, hipStream_t stream) {
#if N_LAUNCH_PER_PHASE
  static bool attr = false;
  if (!attr) { (void)hipFuncSetAttribute((const void*)k_phase<PH>, hipFuncAttributeMaxDynamicSharedMemorySize, LDS_BYTES); attr = true; }
  hipLaunchKernelGGL(k_phase<PH>, dim3(grid), dim3(NTHREADS), LDS_BYTES, stream, p);
#endif
}

extern "C" void kernel_launch(void* const* d_in, const int* in_sizes, int n_in, void* d_out, int out_size, void* d_ws, size_t ws_size, hipStream_t stream) {
  static int grid = 0;
  if (grid == 0) {
    if (n_in != 13 || in_sizes[0] != NTOK * DM || out_size != NTOK * DM || ws_size < WS_END) {
      fprintf(stderr, "kernel_launch: unexpected shapes (n_in %d, in0 %d, out %d, ws %zu)\n", n_in, n_in > 0 ? in_sizes[0] : -1, out_size, ws_size); grid = -1; return; }
    int dev = 0, cus = 0;
    (void)hipGetDevice(&dev); (void)hipDeviceGetAttribute(&cus, hipDeviceAttributeMultiprocessorCount, dev);
#if N_LAUNCH_PER_PHASE
    grid = cus > 0 ? cus : 256;
#else
    int per_cu = 0;
    if (hipFuncSetAttribute((const void*)k_mega, hipFuncAttributeMaxDynamicSharedMemorySize, LDS_BYTES) != hipSuccess) { fprintf(stderr, "kernel_launch: hipFuncSetAttribute failed\n"); grid = -1; return; }
    if (hipOccupancyMaxActiveBlocksPerMultiprocessor(&per_cu, (const void*)k_mega, NTHREADS, LDS_BYTES) != hipSuccess || per_cu < 1) { fprintf(stderr, "kernel_launch: occupancy query failed (%d)\n", per_cu); grid = -1; return; }
    grid = cus;
#endif
  }
  if (grid < 0) return;
  Params p{};
  p.x = (const float*)d_in[0]; p.pos = (const int*)d_in[1]; p.attn_g = (const float*)d_in[2]; p.w_in = (const float*)d_in[3]; p.b_gate = (const float*)d_in[4];
  p.gq = (const float*)d_in[5]; p.gkv = (const float*)d_in[6]; p.w_uq = (const float*)d_in[7]; p.w_ukv = (const float*)d_in[8]; p.w_om = (const float*)d_in[9];
  p.w_od = (const float*)d_in[10]; p.w_out = (const float*)d_in[11]; p.final_g = (const float*)d_in[12];
  p.out = (float*)d_out; p.ws = (unsigned char*)d_ws;
  for (int i = 0; i < 32; ++i) p.inv_freq[i] = powf(10000.0f, -(float)(2 * i) / 64.0f);
#if N_LAUNCH_PER_PHASE
  launch_phase<0>(p, grid, stream); launch_phase<1>(p, grid, stream); launch_phase<2>(p, grid, stream); launch_phase<3>(p, grid, stream);
  launch_phase<4>(p, grid, stream); launch_phase<5>(p, grid, stream); launch_phase<6>(p, grid, stream); launch_phase<7>(p, grid, stream);
  launch_phase<8>(p, grid, stream); launch_phase<9>(p, grid, stream); launch_phase<10>(p, grid, stream);
#else
  (void)hipMemsetAsync((unsigned char*)d_out + OUT_BAR_OFF, 0, 256, stream);
  void* args[] = {&p};
  hipError_t e = hipLaunchCooperativeKernel((const void*)k_mega, dim3(grid), dim3(NTHREADS), args, LDS_BYTES, stream);
  if (e != hipSuccess) fprintf(stderr, "cooperative launch failed: %s (grid %d)\n", hipGetErrorString(e), grid);
#endif
}
```

```cpp
#include <hip/hip_runtime.h>
#include <hip/hip_cooperative_groups.h>
#include <cstdio>
#include <cstdint>
#include <cmath>
namespace cg = cooperative_groups;

#ifndef N_LAUNCH_PER_PHASE
#define N_LAUNCH_PER_PHASE 0
#endif

#define LAS __attribute__((address_space(3)))
typedef unsigned short bf16_t;
using bf16x8 = __attribute__((ext_vector_type(8))) short;
using s16x4  = __attribute__((ext_vector_type(4))) short;
using f32x4  = __attribute__((ext_vector_type(4))) float;
using f32x16 = __attribute__((ext_vector_type(16))) float;
using u32x4  = __attribute__((ext_vector_type(4))) unsigned;
using u32x2  = __attribute__((ext_vector_type(2))) unsigned;

constexpr int SEQ = 8192, NBATCH = 4, DM = 1024, NTOK = NBATCH * SEQ, INW = 8096;
constexpr int NTHREADS = 512;
constexpr float RMS_EPS = 1e-6f;
constexpr float LOG2E = 1.4426950408889634f;
constexpr size_t MiB = 1ull << 20;
constexpr size_t WS_WIN = 0, WS_WUQ = 16 * MiB, WS_WUKV = WS_WUQ + MiB / 2, WS_WOM = 17 * MiB, WS_WOD = 18 * MiB, WS_WOUT = 19 * MiB,
                 WS_LSE = 21 * MiB, WS_COS = 24 * MiB, WS_SIN = 28 * MiB, WS_ZD = 32 * MiB, WS_A2 = 64 * MiB, WS_A1 = 96 * MiB,
                 WS_QD = 128 * MiB, WS_KD = 224 * MiB, WS_VD = 320 * MiB, WS_OG = 416 * MiB, WS_END = 512 * MiB,
                 WS_CQ = 128 * MiB, WS_CKVR = 144 * MiB, WS_ZM = 160 * MiB, WS_MQ = 192 * MiB, WS_MK = 240 * MiB, WS_MV = 288 * MiB,
                 WS_GM = 320 * MiB, WS_GD = 384 * MiB, WS_MERGED = 128 * MiB, WS_PRE = 192 * MiB;
constexpr size_t OUT_BAR_OFF = 64 * MiB;
constexpr int EPI_ROWB = 520;
constexpr int LDS_MISC = 256 * EPI_ROWB;
constexpr int LDS_BYTES = LDS_MISC + 2048;

struct Params {
  const float* x; const int* pos; const float* attn_g; const float* w_in; const float* b_gate; const float* gq; const float* gkv;
  const float* w_uq; const float* w_ukv; const float* w_om; const float* w_od; const float* w_out; const float* final_g;
  float* out; unsigned char* ws;
  float inv_freq[32];
  int ngrid; int pad_;
};

extern __shared__ __attribute__((aligned(16))) unsigned char smem[];

#define LOG2E_F 1.4426950408889634f
__device__ __forceinline__ unsigned cvtpk(float lo, float hi) {
  typedef float f32x2_t __attribute__((ext_vector_type(2))); typedef __bf16 bf16x2_t __attribute__((ext_vector_type(2)));
  const f32x2_t v = {lo, hi}; const bf16x2_t r = __builtin_convertvector(v, bf16x2_t); return __builtin_bit_cast(unsigned, r);
}
__device__ __forceinline__ void st16_wt(void* p, u32x4 v) { asm volatile("global_store_dwordx4 %0, %1, off sc1\n\ts_nop 1" :: "v"(p), "v"(v) : "memory"); }
__device__ __forceinline__ float bf2f(unsigned short v) { return __uint_as_float(((unsigned)v) << 16); }
__device__ __forceinline__ float bflo(unsigned w) { return __uint_as_float(w << 16); }
__device__ __forceinline__ float bfhi(unsigned w) { return __uint_as_float(w & 0xffff0000u); }
__device__ __forceinline__ float sigmoidf_(float v) { return __builtin_amdgcn_rcpf(1.f + __builtin_amdgcn_exp2f(-LOG2E_F * v)); }
__device__ __forceinline__ float wave_sum(float v) {
#pragma unroll
  for (int o = 32; o > 0; o >>= 1) v += __shfl_xor(v, o);
  return v;
}
__device__ __forceinline__ int otid() { int t = threadIdx.x; asm volatile("" : "+v"(t)); return t; }
#define GRIDX (P.ngrid)
__device__ __forceinline__ int vcu_id_(const int G) { const int bx = blockIdx.x; return (G % 8 == 0) ? (bx % 8) * (G / 8) + bx / 8 : bx; }

constexpr int BK = 64, HTB = 128 * BK * 2;
__device__ __forceinline__ int lds_byte(int r, int c) {
  int st = (r >> 4) * 2 + (c >> 5), rr = r & 15, cc = c & 31, ob = rr * 64 + cc * 2;
  return st * 1024 + (ob ^ (((ob >> 9) & 1) << 5));
}
__device__ __forceinline__ void stage_rc(int b, int& R, int& C) {
  int st = b / 1024, sb = b % 1024, swz = sb ^ (((sb >> 9) & 1) << 5);
  R = (st >> 1) * 16 + swz / 64; C = (st & 1) * 32 + (swz % 64) / 2;
}

enum { M_IN = 0, M_UQ = 1, M_UKV = 2, M_OUT1 = 3, M_OUT2 = 4, M_FINAL = 5, M_FINALN = 6, M_OUT12 = 7 };

__device__ __forceinline__ void st4bf(bf16_t* p, f32x4 v) { u32x2 w; w.x = cvtpk(v[0], v[1]); w.y = cvtpk(v[2], v[3]); *(u32x2*)p = w; }

template <int TYPE>
__device__ __forceinline__ void epi_in(const Params& P, const f32x4 (&acc)[2][2][4][2], bf16_t* dst, const int ld, const int col0, const float* bias, const float qs,
                                       const int pm, const int wr, const int wc, const int fr, const int fq) {
  LAS unsigned char* lds = (LAS unsigned char*)smem;
  const float* cosT = (const float*)(P.ws + WS_COS); const float* sinT = (const float*)(P.ws + WS_SIN);
  const int fi = (wc & 1) * 16 + fq * 4;
  f32x4 csA[4], snA[4], bbA[2][2];
  if constexpr (TYPE == 2) {
#pragma unroll
    for (int bj = 0; bj < 2; ++bj) { const int lc = (bj * 2 + (wc >> 1)) * 64 + fi; bbA[bj][0] = *(const f32x4*)(bias + lc); bbA[bj][1] = *(const f32x4*)(bias + lc + 32); }
  }
#pragma unroll
  for (int ai = 0; ai < 2; ++ai) {
    if constexpr (TYPE == 3) {
#pragma unroll
      for (int m = 0; m < 4; ++m) { const size_t row = (size_t)(pm * 256 + ai * 128 + wr * 64 + m * 16 + fr);
        csA[m] = *(const f32x4*)(cosT + row * 32 + fi); snA[m] = *(const f32x4*)(sinT + row * 32 + fi); }
    }
#pragma unroll
    for (int m = 0; m < 4; ++m) {
      const int lr = ai * 128 + wr * 64 + m * 16 + fr;
      f32x4 cs = {1.f, 1.f, 1.f, 1.f}, sn = {0.f, 0.f, 0.f, 0.f};
      if constexpr (TYPE == 3) { cs = csA[m]; sn = snA[m]; }
#pragma unroll
      for (int bj = 0; bj < 2; ++bj) {
        const int lc = (bj * 2 + (wc >> 1)) * 64 + fi;
        f32x4 v0 = acc[ai][bj][m][0], v1 = acc[ai][bj][m][1];
        if constexpr (TYPE == 1) {
#pragma unroll
          for (int j = 0; j < 4; ++j) { v0[j] = v0[j] * sigmoidf_(v0[j]); v1[j] = v1[j] * sigmoidf_(v1[j]); }
        } else if constexpr (TYPE == 2) {
          const f32x4 b0 = bbA[bj][0], b1 = bbA[bj][1];
#pragma unroll
          for (int j = 0; j < 4; ++j) { v0[j] = sigmoidf_(v0[j] + b0[j]); v1[j] = sigmoidf_(v1[j] + b1[j]); }
        } else if constexpr (TYPE == 3) {
#pragma unroll
          for (int j = 0; j < 4; ++j) { const float a = v0[j], b = v1[j]; v0[j] = (a * cs[j] - b * sn[j]) * qs; v1[j] = (b * cs[j] + a * sn[j]) * qs; }
        }
        u32x2 w0, w1; w0.x = cvtpk(v0[0], v0[1]); w0.y = cvtpk(v0[2], v0[3]); w1.x = cvtpk(v1[0], v1[1]); w1.y = cvtpk(v1[2], v1[3]);
        *(LAS u32x2*)(lds + lr * EPI_ROWB + lc * 2) = w0;
        *(LAS u32x2*)(lds + lr * EPI_ROWB + lc * 2 + 64) = w1;
      }
    }
  }
  __syncthreads();
  const int t = otid();
  bf16_t* drow = dst + (size_t)pm * 256 * ld + col0;
#pragma unroll 4
  for (int i = 0; i < 16; ++i) {
    const int ch = t + 512 * i, r = ch >> 5, cc = ch & 31;
    const u32x2 a = *(const LAS u32x2*)(lds + r * EPI_ROWB + cc * 16), b = *(const LAS u32x2*)(lds + r * EPI_ROWB + cc * 16 + 8);
    u32x4 w = {a.x, a.y, b.x, b.y};
    st16_wt(drow + (size_t)r * ld + cc * 8, w);
  }
}

template <int MODE>
__device__ __forceinline__ void gemm_epilogue(const Params& P, f32x4 (&acc)[2][2][4][2], const int pm, const int pn, const int wr, const int wc, const int fr, const int fq) {
  unsigned char* ws = P.ws;
  const int row0 = pm * 256 + wr * 64 + fr;
  if constexpr (MODE == M_IN) {
    bf16_t* dst; int ld, col0, type; const float* bias = nullptr; float qs = 1.f;
    if (pn == 0)      { type = 0; dst = (bf16_t*)(ws + WS_CQ);   ld = 256;  col0 = 0; }
    else if (pn == 1) { type = 0; dst = (bf16_t*)(ws + WS_CKVR); ld = 256;  col0 = 0; }
    else if (pn < 4)  { type = 1; dst = (bf16_t*)(ws + WS_ZM);   ld = 512;  col0 = (pn - 2) * 256; }
    else if (pn < 8)  { type = 2; dst = (bf16_t*)(ws + WS_GM);   ld = 1024; col0 = (pn - 4) * 256; bias = P.b_gate + col0; }
    else if (pn < 12) { type = 2; dst = (bf16_t*)(ws + WS_GD);   ld = 1024; col0 = (pn - 8) * 256; bias = P.b_gate + 1024 + col0; }
    else if (pn < 18) { type = 3; dst = (bf16_t*)(ws + WS_QD);   ld = 1536; col0 = (pn - 12) * 256; qs = 0.125f; }
    else if (pn < 24) { type = 3; dst = (bf16_t*)(ws + WS_KD);   ld = 1536; col0 = (pn - 18) * 256; }
    else if (pn < 30) { type = 0; dst = (bf16_t*)(ws + WS_VD);   ld = 1536; col0 = (pn - 24) * 256; }
    else              { type = 1; dst = (bf16_t*)(ws + WS_ZD);   ld = 512;  col0 = (pn - 30) * 256; }
    if (type == 0)      epi_in<0>(P, acc, dst, ld, col0, bias, qs, pm, wr, wc, fr, fq);
    else if (type == 1) epi_in<1>(P, acc, dst, ld, col0, bias, qs, pm, wr, wc, fr, fq);
    else if (type == 2) epi_in<2>(P, acc, dst, ld, col0, bias, qs, pm, wr, wc, fr, fq);
    else                epi_in<3>(P, acc, dst, ld, col0, bias, qs, pm, wr, wc, fr, fq);
  } else if constexpr (MODE == M_UQ || MODE == M_UKV) {
    const LAS float* rstd = (const LAS float*)((LAS unsigned char*)smem + LDS_MISC);
    LAS unsigned char* ldsE = (LAS unsigned char*)smem;
    const float* cosT = (const float*)(ws + WS_COS); const float* sinT = (const float*)(ws + WS_SIN);
    bf16_t* MQ = (bf16_t*)(ws + WS_MQ); bf16_t* MK = (bf16_t*)(ws + WS_MK); bf16_t* MV = (bf16_t*)(ws + WS_MV);
    f32x4 cA[4][2], sA[4][2];
#pragma unroll
    for (int ai = 0; ai < 2; ++ai) {
      if constexpr (MODE == M_UQ) { if (wc == 2) {
#pragma unroll
        for (int m = 0; m < 4; ++m) { const size_t row = (size_t)(pm * 256 + ai * 128 + wr * 64 + m * 16 + fr);
          cA[m][0] = *(const f32x4*)(cosT + row * 32 + fq * 8); cA[m][1] = *(const f32x4*)(cosT + row * 32 + fq * 8 + 4);
          sA[m][0] = *(const f32x4*)(sinT + row * 32 + fq * 8); sA[m][1] = *(const f32x4*)(sinT + row * 32 + fq * 8 + 4); }
      } }
#pragma unroll
      for (int m = 0; m < 4; ++m) {
        const int lr = ai * 128 + wr * 64 + m * 16 + fr;
        const int row = pm * 256 + lr;
        const int b = row / SEQ, s = row % SEQ;
        const float rs = rstd[lr];
#pragma unroll
        for (int bj = 0; bj < 2; ++bj) {
          const int head = 2 * pn + bj;
          f32x4 v0 = acc[ai][bj][m][0] * rs, v1 = acc[ai][bj][m][1] * rs;
          const size_t hrow = (size_t)(b * 8 + head) * SEQ + s;
          (void)hrow;
          if constexpr (MODE == M_UQ) { if (wc == 2) {
#pragma unroll
              for (int j = 0; j < 4; ++j) {
                const float c = cA[m][j >> 1][(j & 1) * 2], sn = sA[m][j >> 1][(j & 1) * 2];
                const float a = v0[j], bb = v1[j]; v0[j] = a * c - bb * sn; v1[j] = bb * c + a * sn;
              } } }
          if (MODE == M_UKV || wc < 3) {
            u32x2 w0, w1; w0.x = cvtpk(v0[0], v0[1]); w0.y = cvtpk(v0[2], v0[3]); w1.x = cvtpk(v1[0], v1[1]); w1.y = cvtpk(v1[2], v1[3]);
            const int ic = bj * 128 + wc * 32 + fq * 4;
            *(LAS u32x2*)(ldsE + lr * EPI_ROWB + ic * 2) = w0; *(LAS u32x2*)(ldsE + lr * EPI_ROWB + ic * 2 + 32) = w1;
          }
        }
      }
    }
    __syncthreads();
    {
      const int t = otid();
      const int b = (pm * 256) / SEQ, s0 = (pm * 256) % SEQ;
      constexpr int CPR = (MODE == M_UQ) ? 24 : 32;
#pragma unroll 4
      for (int i = 0; i < CPR / 2; ++i) {
        const int ch = t + 512 * i, r = ch / CPR, c = ch % CPR;
        int hh, icol; bf16_t* dst;
        if constexpr (MODE == M_UQ) { hh = c / 12; const int cc = c % 12; icol = hh * 128 + cc * 8; dst = MQ + ((size_t)(b * 8 + 2 * pn + hh) * SEQ + s0 + r) * 96 + cc * 8; }
        else { hh = c >> 4; const int cc = c & 15; icol = hh * 128 + cc * 8;
          dst = (cc < 8) ? MK + ((size_t)(b * 8 + 2 * pn + hh) * SEQ + s0 + r) * 96 + cc * 8 : MV + ((size_t)(b * 8 + 2 * pn + hh) * SEQ + s0 + r) * 64 + (cc - 8) * 8; }
        const u32x2 a = *(const LAS u32x2*)(ldsE + r * EPI_ROWB + icol * 2), bq = *(const LAS u32x2*)(ldsE + r * EPI_ROWB + icol * 2 + 8);
        *(u32x4*)dst = (u32x4){a.x, a.y, bq.x, bq.y};
      }
    }
  } else if constexpr (MODE == M_OUT1 || MODE == M_OUT2) {
    const bf16_t* G = (const bf16_t*)(ws + (MODE == M_OUT1 ? WS_GM : WS_GD));
    bf16_t* Mg = (bf16_t*)(ws + WS_MERGED);
#pragma unroll
    for (int ai = 0; ai < 2; ++ai) {
      u32x2 gA[4][2][2], tA[4][2][2];
#pragma unroll
      for (int m = 0; m < 4; ++m)
#pragma unroll
        for (int bj = 0; bj < 2; ++bj)
#pragma unroll
          for (int n = 0; n < 2; ++n) {
            const size_t idx = (size_t)(row0 + ai * 128 + m * 16) * 1024 + pn * 256 + bj * 128 + wc * 32 + n * 16 + fq * 4;
            gA[m][bj][n] = *(const u32x2*)(G + idx);
            if constexpr (MODE == M_OUT2) tA[m][bj][n] = *(const u32x2*)(Mg + idx);
          }
#pragma unroll
      for (int m = 0; m < 4; ++m)
#pragma unroll
        for (int bj = 0; bj < 2; ++bj)
#pragma unroll
          for (int n = 0; n < 2; ++n) {
            const size_t idx = (size_t)(row0 + ai * 128 + m * 16) * 1024 + pn * 256 + bj * 128 + wc * 32 + n * 16 + fq * 4;
            const u32x2 g = gA[m][bj][n];
            f32x4 v = acc[ai][bj][m][n];
            v[0] *= bflo(g.x); v[1] *= bfhi(g.x); v[2] *= bflo(g.y); v[3] *= bfhi(g.y);
            if constexpr (MODE == M_OUT2) { const u32x2 t = tA[m][bj][n]; v[0] += bflo(t.x); v[1] += bfhi(t.x); v[2] += bflo(t.y); v[3] += bfhi(t.y); }
            st4bf(Mg + idx, v);
          }
    }
  } else if constexpr (MODE == M_OUT12) {
    const bf16_t* GDp = (const bf16_t*)(ws + WS_GD); bf16_t* Mg = (bf16_t*)(ws + WS_MERGED);
#pragma unroll
    for (int ai = 0; ai < 2; ++ai) {
      u32x2 gdA[4][2][2];
#pragma unroll
      for (int m = 0; m < 4; ++m)
#pragma unroll
        for (int bj = 0; bj < 2; ++bj)
#pragma unroll
          for (int n = 0; n < 2; ++n) gdA[m][bj][n] = *(const u32x2*)(GDp + (size_t)(row0 + ai * 128 + m * 16) * 1024 + pn * 256 + bj * 128 + wc * 32 + n * 16 + fq * 4);
#pragma unroll
      for (int m = 0; m < 4; ++m)
#pragma unroll
        for (int bj = 0; bj < 2; ++bj)
#pragma unroll
          for (int n = 0; n < 2; ++n) {
            const size_t idx = (size_t)(row0 + ai * 128 + m * 16) * 1024 + pn * 256 + bj * 128 + wc * 32 + n * 16 + fq * 4;
            const u32x2 gd = gdA[m][bj][n]; f32x4 v = acc[ai][bj][m][n];
            v[0] *= fmaxf(bflo(gd.x), 1e-30f); v[1] *= fmaxf(bfhi(gd.x), 1e-30f); v[2] *= fmaxf(bflo(gd.y), 1e-30f); v[3] *= fmaxf(bfhi(gd.y), 1e-30f);
            st4bf(Mg + idx, v);
          }
    }
  } else if constexpr (MODE == M_FINALN) {
    LAS unsigned char* lds = (LAS unsigned char*)smem;
    LAS float* part = (LAS float*)lds;
    LAS float* rstdL = (LAS float*)(lds + 4096);
    float* stats = (float*)(ws + WS_ZD);
    unsigned* pctr = (unsigned*)(ws + WS_SIN);
    const int tid = otid();
#pragma unroll
    for (int ai = 0; ai < 2; ++ai)
#pragma unroll
      for (int mh = 0; mh < 2; ++mh) {
        f32x4 xA[2][2][2];
#pragma unroll
        for (int mm = 0; mm < 2; ++mm)
#pragma unroll
          for (int bj = 0; bj < 2; ++bj)
#pragma unroll
            for (int n = 0; n < 2; ++n) {
              const size_t idx = (size_t)(row0 + ai * 128 + (mh * 2 + mm) * 16) * 1024 + pn * 256 + bj * 128 + wc * 32 + n * 16 + fq * 4;
              xA[mm][bj][n] = *(const f32x4*)(P.x + idx);
            }
#pragma unroll
        for (int mm = 0; mm < 2; ++mm) {
          float sq = 0.f;
#pragma unroll
          for (int bj = 0; bj < 2; ++bj)
#pragma unroll
            for (int n = 0; n < 2; ++n) { f32x4 v = acc[ai][bj][mh * 2 + mm][n] + xA[mm][bj][n]; acc[ai][bj][mh * 2 + mm][n] = v;
              sq += v[0] * v[0] + v[1] * v[1] + v[2] * v[2] + v[3] * v[3]; }
          sq += __shfl_xor(sq, 16); sq += __shfl_xor(sq, 32);
          if (fq == 0) part[(ai * 128 + wr * 64 + (mh * 2 + mm) * 16 + fr) * 4 + wc] = sq;
        }
      }
    __syncthreads();
    if (tid < 256) __hip_atomic_store((unsigned*)stats + ((size_t)pm * 4 + pn) * 256 + tid,
                                      __float_as_uint((part[tid * 4 + 0] + part[tid * 4 + 1]) + (part[tid * 4 + 2] + part[tid * 4 + 3])), __ATOMIC_RELAXED, __HIP_MEMORY_SCOPE_AGENT);
    asm volatile("s_waitcnt vmcnt(0)" ::: "memory");
    __syncthreads();
    if (tid == 0) {
      (void)__hip_atomic_fetch_add(pctr + pm, 1u, __ATOMIC_RELAXED, __HIP_MEMORY_SCOPE_AGENT);
      while (__hip_atomic_load(pctr + pm, __ATOMIC_RELAXED, __HIP_MEMORY_SCOPE_AGENT) < 4u) __builtin_amdgcn_s_sleep(1);
    }
    __syncthreads();
    if (tid < 256) {
      unsigned* sp = (unsigned*)stats + (size_t)pm * 4 * 256 + tid;
      const float t0 = __uint_as_float(__hip_atomic_load(sp, __ATOMIC_RELAXED, __HIP_MEMORY_SCOPE_AGENT)), t1 = __uint_as_float(__hip_atomic_load(sp + 256, __ATOMIC_RELAXED, __HIP_MEMORY_SCOPE_AGENT));
      const float t2 = __uint_as_float(__hip_atomic_load(sp + 512, __ATOMIC_RELAXED, __HIP_MEMORY_SCOPE_AGENT)), t3 = __uint_as_float(__hip_atomic_load(sp + 768, __ATOMIC_RELAXED, __HIP_MEMORY_SCOPE_AGENT));
      rstdL[tid] = rsqrtf(((t0 + t1) + (t2 + t3)) * (1.f / DM) + RMS_EPS);
    }
    __syncthreads();
#pragma unroll
    for (int bj = 0; bj < 2; ++bj)
#pragma unroll
      for (int n = 0; n < 2; ++n) {
        const int col = pn * 256 + bj * 128 + wc * 32 + n * 16 + fq * 4;
        const f32x4 g4 = *(const f32x4*)(P.final_g + col);
#pragma unroll
        for (int ai = 0; ai < 2; ++ai)
#pragma unroll
          for (int m = 0; m < 4; ++m) {
            const int lr = ai * 128 + wr * 64 + m * 16 + fr;
            *(f32x4*)(P.out + (size_t)(pm * 256 + lr) * 1024 + col) = acc[ai][bj][m][n] * rstdL[lr] * g4;
          }
      }
  } else {
#pragma unroll
    for (int ai = 0; ai < 2; ++ai)
#pragma unroll
      for (int mh = 0; mh < 2; ++mh) {
        f32x4 xA[2][2][2];
#pragma unroll
        for (int mm = 0; mm < 2; ++mm)
#pragma unroll
          for (int bj = 0; bj < 2; ++bj)
#pragma unroll
            for (int n = 0; n < 2; ++n) {
              const size_t idx = (size_t)(row0 + ai * 128 + (mh * 2 + mm) * 16) * 1024 + pn * 256 + bj * 128 + wc * 32 + n * 16 + fq * 4;
              xA[mm][bj][n] = *(const f32x4*)(P.x + idx);
            }
#pragma unroll
        for (int mm = 0; mm < 2; ++mm)
#pragma unroll
          for (int bj = 0; bj < 2; ++bj)
#pragma unroll
            for (int n = 0; n < 2; ++n) {
              const size_t idx = (size_t)(row0 + ai * 128 + (mh * 2 + mm) * 16) * 1024 + pn * 256 + bj * 128 + wc * 32 + n * 16 + fq * 4;
              *(f32x4*)((float*)(ws + WS_PRE) + idx) = acc[ai][bj][mh * 2 + mm][n] + xA[mm][bj][n];
            }
      }
  }
}

template <int MODE>
__device__ __forceinline__ void gemm_tile(const Params& P, const bf16_t* __restrict__ A, const bf16_t* __restrict__ Bt, const int K, const int pm, const int pnb, const int pn_epi) {
  LAS unsigned char* lds = (LAS unsigned char*)smem;
  const int tid = otid(), wid = __builtin_amdgcn_readfirstlane(tid >> 6), lane = tid & 63, wr = wid >> 2, wc = wid & 3, fr = lane & 15, fq = lane >> 4;
  const int brow = pm * 256, bcol = pnb * 256;
  __syncthreads();
  if constexpr (MODE == M_UQ || MODE == M_UKV) {
    constexpr int NC = (MODE == M_UQ) ? 256 : 128;
    const int r = tid >> 1, hf = tid & 1;
    const bf16_t* ap = A + (size_t)(brow + r) * K + hf * (NC / 2);
    float ss = 0.f;
#pragma unroll
    for (int i = 0; i < NC / 16; ++i) {
      const u32x4 w = *(const u32x4*)(ap + i * 8);
#pragma unroll
      for (int e = 0; e < 4; ++e) { const float a = bflo(w[e]), b = bfhi(w[e]); ss += a * a + b * b; }
    }
    ss += __shfl_xor(ss, 1);
    if (hf == 0) ((LAS float*)(lds + LDS_MISC))[r] = rsqrtf(ss * (1.f / NC) + RMS_EPS);
  }
  unsigned goff[2];
  { int R, C; stage_rc(tid * 16, R, C); goff[0] = (unsigned)(R * K + C) * 2u; goff[1] = goff[0] + (unsigned)(64 * K) * 2u; }
#define SAO(b, h) (((b) * 2 + (h)) * HTB)
#define SBO(b, h) ((4 + (b) * 2 + (h)) * HTB)
#define STAGE(PO, BASE, br, kt) do { const char* _g = (const char*)((BASE) + (size_t)(br) * K + (size_t)(kt) * BK); \
    _Pragma("unroll") for (int _i = 0; _i < 2; ++_i) \
      __builtin_amdgcn_global_load_lds((const unsigned*)(_g + goff[_i]), (LAS unsigned*)(lds + (PO) + wid * 1024 + _i * 8192), 16, 0, 0); } while (0)
#define LDA(dst, b, h) _Pragma("unroll") for (int m = 0; m < 4; ++m) _Pragma("unroll") for (int k = 0; k < 2; ++k) \
    dst[m][k] = *(const LAS bf16x8*)(lds + SAO(b, h) + lds_byte(wr * 64 + m * 16 + fr, k * 32 + fq * 8))
#define LDB(dst, b, h) _Pragma("unroll") for (int n = 0; n < 2; ++n) _Pragma("unroll") for (int k = 0; k < 2; ++k) \
    dst[n][k] = *(const LAS bf16x8*)(lds + SBO(b, h) + lds_byte(wc * 32 + n * 16 + fr, k * 32 + fq * 8))
#define MMA(ai, bj, AT, BT) do { __builtin_amdgcn_s_setprio(1); \
    _Pragma("unroll") for (int m = 0; m < 4; ++m) _Pragma("unroll") for (int n = 0; n < 2; ++n) _Pragma("unroll") for (int k = 0; k < 2; ++k) \
      acc[ai][bj][m][n] = __builtin_amdgcn_mfma_f32_16x16x32_bf16(BT[n][k], AT[m][k], acc[ai][bj][m][n], 0, 0, 0); \
    __builtin_amdgcn_s_setprio(0); } while (0)
#define WAIT_V(n) asm volatile("s_waitcnt vmcnt(" #n ")" ::: "memory")
#define WAIT_L(n) asm volatile("s_waitcnt lgkmcnt(" #n ")" ::: "memory")
#define BAR __builtin_amdgcn_s_barrier()
#define SCHED __builtin_amdgcn_sched_barrier(0)
  f32x4 acc[2][2][4][2] = {};
  bf16x8 At[4][2], B0[2][2], B1[2][2];
  const int nt = K / BK;
  constexpr int NPASS = (MODE == M_OUT12) ? 2 : 1;
#pragma unroll 1
  for (int pass = 0; pass < NPASS; ++pass) {
  const bf16_t* Ap = A; const bf16_t* Bp = Bt;
  if constexpr (MODE == M_OUT12) { if (pass == 1) {
    Ap = (const bf16_t*)(P.ws + WS_A2); Bp = (const bf16_t*)(P.ws + WS_WOD);
    int l2 = lane; asm volatile("" : "+v"(l2)); const int fr2 = l2 & 15, fq2 = l2 >> 4;
    const bf16_t* GMp = (const bf16_t*)(P.ws + WS_GM); const bf16_t* GDp = (const bf16_t*)(P.ws + WS_GD);
#pragma unroll
    for (int ai = 0; ai < 2; ++ai) {
      u32x2 gmA[4][2][2], gdA[4][2][2];
#pragma unroll
      for (int m = 0; m < 4; ++m)
#pragma unroll
        for (int bj = 0; bj < 2; ++bj)
#pragma unroll
          for (int n = 0; n < 2; ++n) {
            const size_t idx = (size_t)(pm * 256 + wr * 64 + fr2 + ai * 128 + m * 16) * 1024 + pn_epi * 256 + bj * 128 + wc * 32 + n * 16 + fq2 * 4;
            gmA[m][bj][n] = *(const u32x2*)(GMp + idx); gdA[m][bj][n] = *(const u32x2*)(GDp + idx);
          }
#pragma unroll
      for (int m = 0; m < 4; ++m)
#pragma unroll
        for (int bj = 0; bj < 2; ++bj)
#pragma unroll
          for (int n = 0; n < 2; ++n) {
            const u32x2 gm = gmA[m][bj][n], gd = gdA[m][bj][n];
            acc[ai][bj][m][n][0] *= bflo(gm.x) * __builtin_amdgcn_rcpf(fmaxf(bflo(gd.x), 1e-30f));
            acc[ai][bj][m][n][1] *= bfhi(gm.x) * __builtin_amdgcn_rcpf(fmaxf(bfhi(gd.x), 1e-30f));
            acc[ai][bj][m][n][2] *= bflo(gm.y) * __builtin_amdgcn_rcpf(fmaxf(bflo(gd.y), 1e-30f));
            acc[ai][bj][m][n][3] *= bfhi(gm.y) * __builtin_amdgcn_rcpf(fmaxf(bfhi(gd.y), 1e-30f));
          }
    }
    __syncthreads();
  } }
  STAGE(SBO(0, 0), Bp, bcol, 0); STAGE(SAO(0, 0), Ap, brow, 0);
  STAGE(SBO(0, 1), Bp, bcol + 128, 0); STAGE(SAO(0, 1), Ap, brow + 128, 0);
  if (wr == 1) BAR;
  WAIT_V(4); BAR;
  STAGE(SBO(1, 0), Bp, bcol, 1); STAGE(SAO(1, 0), Ap, brow, 1); STAGE(SBO(1, 1), Bp, bcol + 128, 1);
  WAIT_V(6); BAR;
  for (int t = 0; t < nt - 2; t += 2) {
    LDB(B0, 0, 0); SCHED; LDA(At, 0, 0); STAGE(SAO(1, 1), Ap, brow + 128, t + 1);
    WAIT_L(8); BAR; WAIT_L(0); MMA(0, 0, At, B0); BAR; SCHED;
    LDB(B1, 0, 1); STAGE(SBO(0, 0), Bp, bcol, t + 2);
    BAR; WAIT_L(0); MMA(0, 1, At, B1); BAR;
    LDA(At, 0, 1); STAGE(SAO(0, 0), Ap, brow, t + 2);
    BAR; WAIT_L(0); MMA(1, 0, At, B0); BAR; SCHED;
    STAGE(SBO(0, 1), Bp, bcol + 128, t + 2);
    WAIT_V(6); BAR; MMA(1, 1, At, B1); BAR;
    LDB(B0, 1, 0); SCHED; LDA(At, 1, 0); STAGE(SAO(0, 1), Ap, brow + 128, t + 2);
    WAIT_L(8); BAR; WAIT_L(0); MMA(0, 0, At, B0); BAR; SCHED;
    LDB(B1, 1, 1); STAGE(SBO(1, 0), Bp, bcol, t + 3);
    BAR; WAIT_L(0); MMA(0, 1, At, B1); BAR;
    LDA(At, 1, 1); STAGE(SAO(1, 0), Ap, brow, t + 3);
    BAR; WAIT_L(0); MMA(1, 0, At, B0); BAR; SCHED;
    STAGE(SBO(1, 1), Bp, bcol + 128, t + 3);
    WAIT_V(6); BAR; MMA(1, 1, At, B1); BAR;
  }
  { LDB(B0, 0, 0); LDA(At, 0, 0); STAGE(SAO(1, 1), Ap, brow + 128, nt - 1);
    BAR; WAIT_L(0); MMA(0, 0, At, B0); BAR;
    LDB(B1, 0, 1); BAR; WAIT_L(0); MMA(0, 1, At, B1); BAR;
    LDA(At, 0, 1); WAIT_V(4); BAR; WAIT_L(0); MMA(1, 0, At, B0); MMA(1, 1, At, B1); BAR; }
  { LDB(B0, 1, 0); LDA(At, 1, 0); WAIT_V(2); BAR; WAIT_L(0); MMA(0, 0, At, B0); BAR;
    LDB(B1, 1, 1); WAIT_V(0); BAR; WAIT_L(0); MMA(0, 1, At, B1); BAR;
    LDA(At, 1, 1); BAR; WAIT_L(0); MMA(1, 0, At, B0); MMA(1, 1, At, B1); BAR; }
  if (wr == 0) BAR;
  }
  { int l2 = lane; asm volatile("" : "+v"(l2));
    gemm_epilogue<MODE>(P, acc, pm, pn_epi, wr, wc, l2 & 15, l2 >> 4); }
#undef SAO
#undef SBO
#undef STAGE
#undef LDA
#undef LDB
#undef MMA
}


template <int MODE>
__device__ __forceinline__ void gemm_stream(const Params& P, const bf16_t* __restrict__ A, const bf16_t* __restrict__ Bt, const int K, const int pn_lo, const int npn, const int pnb_lo) {
  LAS unsigned char* lds = (LAS unsigned char*)smem;
  const int G = GRIDX, u0 = vcu_id_(GRIDX), nunits = (NTOK / 256) * npn;
  if (u0 >= nunits) return;
  const int nmine = (nunits - u0 + G - 1) / G;
  const int tid = otid(), wid = __builtin_amdgcn_readfirstlane(tid >> 6), lane = tid & 63, wr = wid >> 2, wc = wid & 3, fr = lane & 15, fq = lane >> 4;
  const int nt = K / BK;
  unsigned goff[2];
  { int R, C; stage_rc(tid * 16, R, C); goff[0] = (unsigned)(R * K + C) * 2u; goff[1] = goff[0] + (unsigned)(64 * K) * 2u; }
  const size_t half = (size_t)128 * K;
#define SAO(b, h) (((b) * 2 + (h)) * HTB)
#define SBO(b, h) ((4 + (b) * 2 + (h)) * HTB)
#define STAGE(PO, BASE, kt) do { const char* _g = (const char*)((BASE) + (size_t)(kt) * BK); \
    _Pragma("unroll") for (int _i = 0; _i < 2; ++_i) \
      __builtin_amdgcn_global_load_lds((const unsigned*)(_g + goff[_i]), (LAS unsigned*)(lds + (PO) + wid * 1024 + _i * 8192), 16, 0, 0); } while (0)
#define LDA(dst, b, h) _Pragma("unroll") for (int m = 0; m < 4; ++m) _Pragma("unroll") for (int k = 0; k < 2; ++k) \
    dst[m][k] = *(const LAS bf16x8*)(lds + SAO(b, h) + lds_byte(wr * 64 + m * 16 + fr, k * 32 + fq * 8))
#define LDB(dst, b, h) _Pragma("unroll") for (int n = 0; n < 2; ++n) _Pragma("unroll") for (int k = 0; k < 2; ++k) \
    dst[n][k] = *(const LAS bf16x8*)(lds + SBO(b, h) + lds_byte(wc * 32 + n * 16 + fr, k * 32 + fq * 8))
#define MMA(ai, bj, AT, BT) do { __builtin_amdgcn_s_setprio(1); \
    _Pragma("unroll") for (int m = 0; m < 4; ++m) _Pragma("unroll") for (int n = 0; n < 2; ++n) _Pragma("unroll") for (int k = 0; k < 2; ++k) \
      acc[ai][bj][m][n] = __builtin_amdgcn_mfma_f32_16x16x32_bf16(BT[n][k], AT[m][k], acc[ai][bj][m][n], 0, 0, 0); \
    __builtin_amdgcn_s_setprio(0); } while (0)
  f32x4 acc[2][2][4][2] = {};
  bf16x8 At[4][2], B0[2][2], B1[2][2];
  int uiN = 0, ktN = 0, pmP, plP, ktP;
  const bf16_t *aP, *bP, *aN, *bN;
  { const int u = u0, pm = u / npn, pl = u - pm * npn; pmP = pm; plP = pl; ktP = 0;
    aP = A + (size_t)pm * 256 * K; bP = Bt + (size_t)(pnb_lo + pl) * 256 * K; aN = aP; bN = bP; }
  int pmN = pmP, plN = plP;
#define ADVANCE_N() do { ktN += 2; if (ktN == nt) { if (uiN + 1 < nmine) { ++uiN; ktN = 0; const int u = u0 + uiN * G; pmN = u / npn; plN = u - pmN * npn; \
      aN = A + (size_t)pmN * 256 * K; bN = Bt + (size_t)(pnb_lo + plN) * 256 * K; } else { ktN = nt - 2; } } } while (0)
  __syncthreads();
  STAGE(SBO(0, 0), bP, 0); STAGE(SAO(0, 0), aP, 0);
  STAGE(SBO(0, 1), bP + half, 0); STAGE(SAO(0, 1), aP + half, 0);
  if (wr == 1) BAR;
  WAIT_V(4); BAR;
  STAGE(SBO(1, 0), bP, 1); STAGE(SAO(1, 0), aP, 1); STAGE(SBO(1, 1), bP + half, 1);
  WAIT_V(6); BAR;
  ADVANCE_N();
  const int npairs = nmine * (nt >> 1);
  for (int q = 0; q < npairs; ++q) {
    LDB(B0, 0, 0); SCHED; LDA(At, 0, 0); STAGE(SAO(1, 1), aP + half, ktP + 1);
    WAIT_L(8); BAR; WAIT_L(0); MMA(0, 0, At, B0); BAR; SCHED;
    LDB(B1, 0, 1); STAGE(SBO(0, 0), bN, ktN);
    BAR; WAIT_L(0); MMA(0, 1, At, B1); BAR;
    LDA(At, 0, 1); STAGE(SAO(0, 0), aN, ktN);
    BAR; WAIT_L(0); MMA(1, 0, At, B0); BAR; SCHED;
    STAGE(SBO(0, 1), bN + half, ktN);
    WAIT_V(6); BAR; MMA(1, 1, At, B1); BAR;
    LDB(B0, 1, 0); SCHED; LDA(At, 1, 0); STAGE(SAO(0, 1), aN + half, ktN);
    WAIT_L(8); BAR; WAIT_L(0); MMA(0, 0, At, B0); BAR; SCHED;
    LDB(B1, 1, 1); STAGE(SBO(1, 0), bN, ktN + 1);
    BAR; WAIT_L(0); MMA(0, 1, At, B1); BAR;
    LDA(At, 1, 1); STAGE(SAO(1, 0), aN, ktN + 1);
    BAR; WAIT_L(0); MMA(1, 0, At, B0); BAR; SCHED;
    STAGE(SBO(1, 1), bN + half, ktN + 1);
    WAIT_V(6); BAR; MMA(1, 1, At, B1); BAR;
    if (ktP + 2 == nt) {
      { int l2 = lane; asm volatile("" : "+v"(l2));
        gemm_epilogue<MODE>(P, acc, pmP, pn_lo + plP, wr, wc, l2 & 15, l2 >> 4); }
#pragma unroll
      for (int ai = 0; ai < 2; ++ai)
#pragma unroll
        for (int bj = 0; bj < 2; ++bj)
#pragma unroll
          for (int m = 0; m < 4; ++m)
#pragma unroll
            for (int n = 0; n < 2; ++n) acc[ai][bj][m][n] = (f32x4){0.f, 0.f, 0.f, 0.f};
    }
    aP = aN; bP = bN; ktP = ktN; pmP = pmN; plP = plN;
    ADVANCE_N();
  }
  WAIT_V(0);
  if (wr == 0) BAR;
  __syncthreads();
#undef SAO
#undef SBO
#undef STAGE
#undef LDA
#undef LDB
#undef MMA
#undef ADVANCE_N
}

#define KSWZ(row, colB) ((row) * 256 + ((colB) ^ (((row) & 7) << 4)))
#define SBAR() __builtin_amdgcn_sched_barrier(0)
constexpr int AT_NBUF = 3, AT_V = 64 * 64 * 2, AT_K = 64 * 256, AT_KOFF = AT_NBUF * AT_V, AT_WSOFF = AT_NBUF * (AT_V + AT_K);
__device__ __forceinline__ int crow(int r, int hi) { return (r & 3) + 8 * (r >> 2) + 4 * hi; }
__device__ __forceinline__ int v_st(int k, int c) { const int kk = (k & ~0xC) | ((k & 4) << 1) | ((k & 8) >> 1); return ((kk >> 3) * 2 + (c >> 5)) * 512 + ((kk & 7) * 32 + (c & 31)) * 2; }
__device__ __forceinline__ int v_rd_base(int lane) { return ((lane & 3) << 3) | (((lane >> 2) & 3) << 6) | (((lane >> 4) & 1) << 5) | (((lane >> 5) & 1) << 8); }
constexpr int v_rd_off(int d0, int ks, int half) { return d0 * 512 + ks * 2048 + half * 1024; }
template <int OFF> __device__ __forceinline__ s16x4 tr_read(int vb) {
  s16x4 r; asm volatile("ds_read_b64_tr_b16 %0, %1 offset:%2" : "=&v"(r) : "v"(vb), "i"(OFF) : "memory"); return r;
}
template <int D0> __device__ __forceinline__ void pv_one(f32x16& od, int vb, bf16x8 pa0, bf16x8 pa1, bf16x8 pa2, bf16x8 pa3) {
  const s16x4 l0 = tr_read<v_rd_off(D0, 0, 0)>(vb), h0 = tr_read<v_rd_off(D0, 0, 1)>(vb), l1 = tr_read<v_rd_off(D0, 1, 0)>(vb), h1 = tr_read<v_rd_off(D0, 1, 1)>(vb);
  const s16x4 l2 = tr_read<v_rd_off(D0, 2, 0)>(vb), h2 = tr_read<v_rd_off(D0, 2, 1)>(vb), l3 = tr_read<v_rd_off(D0, 3, 0)>(vb), h3 = tr_read<v_rd_off(D0, 3, 1)>(vb);
  asm volatile("s_waitcnt lgkmcnt(0)" ::: "memory"); SBAR();
#define PK(L, H) (bf16x8){L[0], L[1], L[2], L[3], H[0], H[1], H[2], H[3]}
  od = __builtin_amdgcn_mfma_f32_32x32x16_bf16(pa0, PK(l0, h0), od, 0, 0, 0);
  od = __builtin_amdgcn_mfma_f32_32x32x16_bf16(pa1, PK(l1, h1), od, 0, 0, 0);
  od = __builtin_amdgcn_mfma_f32_32x32x16_bf16(pa2, PK(l2, h2), od, 0, 0, 0);
  od = __builtin_amdgcn_mfma_f32_32x32x16_bf16(pa3, PK(l3, h3), od, 0, 0, 0);
#undef PK
}
__device__ __forceinline__ void partialSM(f32x16& p0, f32x16& p1, float& m_reg, float& mn, float& alpha, const float C, const float thr_raw) {
  float pmax = p0[0];
#pragma unroll
  for (int r = 1; r < 16; ++r) pmax = fmaxf(pmax, p0[r]);
#pragma unroll
  for (int r = 0; r < 16; ++r) pmax = fmaxf(pmax, p1[r]);
  { auto rr = __builtin_amdgcn_permlane32_swap(__float_as_uint(pmax), __float_as_uint(pmax), false, false);
    pmax = fmaxf(__uint_as_float(rr[0]), __uint_as_float(rr[1])); }
  if (__builtin_expect(__all(pmax - m_reg <= thr_raw), 1)) { mn = m_reg; alpha = 1.f; }
  else { mn = fmaxf(m_reg, pmax); alpha = __builtin_amdgcn_exp2f((m_reg - mn) * C); m_reg = mn; }
  const float mnC = -mn * C;
#pragma unroll
  for (int r = 0; r < 16; ++r) p0[r] = fmaf(p0[r], C, mnC);
#pragma unroll
  for (int r = 0; r < 16; ++r) p1[r] = fmaf(p1[r], C, mnC);
#pragma unroll
  for (int r = 0; r < 16; ++r) p0[r] = __builtin_amdgcn_exp2f(p0[r]);
}
__device__ __forceinline__ void finishSM(f32x16& p0, f32x16& p1, float alpha, float& l_reg, bf16x8& pa0, bf16x8& pa1, bf16x8& pa2, bf16x8& pa3) {
#pragma unroll
  for (int r = 0; r < 16; ++r) p1[r] = __builtin_amdgcn_exp2f(p1[r]);
  float ps = 0;
#pragma unroll
  for (int r = 0; r < 16; ++r) ps += p0[r];
#pragma unroll
  for (int r = 0; r < 16; ++r) ps += p1[r];
  { auto rr = __builtin_amdgcn_permlane32_swap(__float_as_uint(ps), __float_as_uint(ps), false, false);
    ps = __uint_as_float(rr[0]) + __uint_as_float(rr[1]); }
  l_reg = l_reg * alpha + ps;
#define PK4(Pv, BASE, OUT) do { unsigned a0 = cvtpk(Pv[BASE + 0], Pv[BASE + 1]), a1 = cvtpk(Pv[BASE + 2], Pv[BASE + 3]);   \
    unsigned b0 = cvtpk(Pv[BASE + 4], Pv[BASE + 5]), b1 = cvtpk(Pv[BASE + 6], Pv[BASE + 7]);                              \
    auto r0 = __builtin_amdgcn_permlane32_swap(a0, b0, false, false); auto r1 = __builtin_amdgcn_permlane32_swap(a1, b1, false, false); \
    u32x4 w = {r0[0], r1[0], r0[1], r1[1]}; OUT = *reinterpret_cast<bf16x8*>(&w); } while (0)
  PK4(p0, 0, pa0); PK4(p0, 8, pa1); PK4(p1, 0, pa2); PK4(p1, 8, pa3);
#undef PK4
}

template <int NQ, bool MASK>
__device__ __forceinline__ void attn_body(const bf16_t* __restrict__ Qb, const long ldq, const bf16_t* __restrict__ Kh, const long ldk,
                                          const bf16_t* __restrict__ Vh, const long ldv, const int NT, const float C, const float thr_raw, const int mdelta,
                                          f32x16 (&o)[2], float& m_reg, float& l_reg) {
  LAS unsigned char* lds = (LAS unsigned char*)smem;
  const int tid = otid(), wid = __builtin_amdgcn_readfirstlane(tid >> 6), lane = tid & 63, r32 = lane & 31, hi = lane >> 5;
  LAS float* wsl = (LAS float*)(lds + AT_WSOFF) + wid * 64; LAS float* al_l = wsl + 32;
  m_reg = MASK ? -30000.f : -1e30f; l_reg = 0.f;
  o[0] = f32x16{}; o[1] = f32x16{};
  bf16x8 qr[NQ];
  const bf16_t* Qw = Qb + (long)(wid * 32 + r32) * ldq + hi * 8;
#pragma unroll
  for (int d0 = 0; d0 < NQ; ++d0) qr[d0] = *(const bf16x8*)(Qw + d0 * 16);
  int kr0, kc0, kr1 = 0, kc1 = 0;
  if constexpr (NQ == 6) { kr0 = tid / 12; kc0 = (tid % 12) * 8; const int c1 = 512 + (tid & 255); kr1 = c1 / 12; kc1 = (c1 % 12) * 8; }
  else { kr0 = tid >> 3; kc0 = (tid & 7) * 8; }
  const int vr = tid >> 3, vc = (tid & 7) * 8;
  const int kst0 = KSWZ(kr0, kc0 * 2), kst1 = KSWZ(kr1, kc1 * 2), vst = v_st(vr, vc);
  const int vb0 = (int)(unsigned)(uintptr_t)lds + v_rd_base(lane);
  struct { bf16x8 v, k0, k1; } sr_[2];
#define SLOAD(i, kk0) do { sr_[i].v = *(const bf16x8*)(Vh + (long)((kk0) + vr) * ldv + vc); sr_[i].k0 = *(const bf16x8*)(Kh + (long)((kk0) + kr0) * ldk + kc0); \
    if constexpr (NQ == 6) sr_[i].k1 = *(const bf16x8*)(Kh + (long)((kk0) + kr1) * ldk + kc1); } while (0)
#define SWRITE(b, i) do { *(LAS bf16x8*)(lds + (b) * AT_V + vst) = sr_[i].v; *(LAS bf16x8*)(lds + AT_KOFF + (b) * AT_K + kst0) = sr_[i].k0; \
    if constexpr (NQ == 6) *(LAS bf16x8*)(lds + AT_KOFF + (b) * AT_K + kst1) = sr_[i].k1; } while (0)
#define SWAIT() do { if constexpr (NQ == 6) asm volatile("s_waitcnt vmcnt(3)" ::: "memory"); else asm volatile("s_waitcnt vmcnt(2)" ::: "memory"); } while (0)
#define RESC(a) do { if (__any((a) < 1.f)) { if (hi == 0) al_l[r32] = (a); asm volatile("s_waitcnt lgkmcnt(0)" ::: "memory"); \
    _Pragma("unroll") for (int d = 0; d < 2; ++d) _Pragma("unroll") for (int r = 0; r < 16; ++r) o[d][r] *= al_l[crow(r, hi)]; } } while (0)
#define QKT(P0, P1, b, tile) do { P0 = f32x16{}; P1 = f32x16{}; \
    _Pragma("unroll") for (int d0 = 0; d0 < NQ; ++d0) { const int cb = (d0 * 16 + hi * 8) * 2; \
      const bf16x8 b0 = *(const LAS bf16x8*)(lds + AT_KOFF + (b) * AT_K + KSWZ(r32, cb)); \
      const bf16x8 b1 = *(const LAS bf16x8*)(lds + AT_KOFF + (b) * AT_K + KSWZ(32 + r32, cb)); \
      P0 = __builtin_amdgcn_mfma_f32_32x32x16_bf16(b0, qr[d0], P0, 0, 0, 0); \
      P1 = __builtin_amdgcn_mfma_f32_32x32x16_bf16(b1, qr[d0], P1, 0, 0, 0); } \
    if constexpr (MASK) { const int dl = mdelta + (tile) * 64 - (wid * 32 + r32) + 4 * hi; \
      _Pragma("unroll") for (int r = 0; r < 16; ++r) { const int dd = dl + (r & 3) + 8 * (r >> 2); \
        if ((unsigned)(dd + 64) > 128u) P0[r] = -1e30f; if ((unsigned)(dd + 96) > 128u) P1[r] = -1e30f; } } } while (0)
#define PV(b) do { pv_one<0>(o[0], vb0 + (b) * AT_V, pa0, pa1, pa2, pa3); pv_one<1>(o[1], vb0 + (b) * AT_V, pa0, pa1, pa2, pa3); } while (0)
  f32x16 pA0, pA1, pB0, pB1; float mnA = 0.f, mnB = 0.f, alA = 1.f, alB = 1.f; bf16x8 pa0, pa1, pa2, pa3;
  int jlo = 0, jhi = NT - 1;
  if constexpr (MASK) {
    const int a = 32 * wid - 127 - mdelta + 63, b = 32 * wid + 95 - mdelta;
    jlo = a >= 0 ? a / 64 : -((-a + 63) / 64); jhi = b >= 0 ? b / 64 : -((-b + 63) / 64);
    jlo = jlo < 0 ? 0 : jlo; jhi = jhi > NT - 1 ? NT - 1 : jhi;
  }
#define NEED(j) (!MASK || ((j) >= jlo && (j) <= jhi))
  SLOAD(0, 0); asm volatile("s_waitcnt vmcnt(0)" ::: "memory"); SWRITE(0, 0); __syncthreads();
  if (NEED(0)) { QKT(pA0, pA1, 0, 0); partialSM(pA0, pA1, m_reg, mnA, alA, C, thr_raw); }
  SLOAD(1, 64); if (2 < NT) SLOAD(0, 128);
  SWAIT(); SWRITE(1, 1); __syncthreads();
#define STEP(PC0, PC1, ALC, MNC, PP0, PP1, ALP, BC, BP, BN, T) do { \
    SBAR(); QKT(PC0, PC1, BC, T); \
    finishSM(PP0, PP1, ALP, l_reg, pa0, pa1, pa2, pa3); SBAR(); \
    if ((T) + 2 < NT) { if ((T) & 1) SLOAD(1, ((T) + 2) * 64); else SLOAD(0, ((T) + 2) * 64); } SBAR(); \
    PV(BP); partialSM(PC0, PC1, m_reg, MNC, ALC, C, thr_raw); \
    SWAIT(); if ((T) & 1) SWRITE(BN, 0); else SWRITE(BN, 1); \
    RESC(ALC); __syncthreads(); } while (0)
  for (int j = 1; j + 1 < NT; j += 6) {
    STEP(pB0, pB1, alB, mnB, pA0, pA1, alA, 1, 0, 2, j);
    STEP(pA0, pA1, alA, mnA, pB0, pB1, alB, 2, 1, 0, j + 1);
    STEP(pB0, pB1, alB, mnB, pA0, pA1, alA, 0, 2, 1, j + 2);
    STEP(pA0, pA1, alA, mnA, pB0, pB1, alB, 1, 0, 2, j + 3);
    STEP(pB0, pB1, alB, mnB, pA0, pA1, alA, 2, 1, 0, j + 4);
    STEP(pA0, pA1, alA, mnA, pB0, pB1, alB, 0, 2, 1, j + 5);
  }
  SBAR(); QKT(pB0, pB1, 1, NT - 1);
  finishSM(pA0, pA1, alA, l_reg, pa0, pa1, pa2, pa3); SBAR();
  PV(0); partialSM(pB0, pB1, m_reg, mnB, alB, C, thr_raw);
  RESC(alB);
  finishSM(pB0, pB1, alB, l_reg, pa0, pa1, pa2, pa3); SBAR();
  PV(1);
#undef STEP
#undef NEED
  if (hi == 0) wsl[r32] = l_reg;
  asm volatile("s_waitcnt lgkmcnt(0)" ::: "memory");
#pragma unroll
  for (int r = 0; r < 16; ++r) { const float rl = __builtin_amdgcn_rcpf(wsl[crow(r, hi)]); o[0][r] *= rl; o[1][r] *= rl; }
#undef SLOAD
#undef SWRITE
#undef SWAIT
#undef RESC
#undef QKT
#undef PV
}

constexpr int DL_V = 0, DL_K = 6 * 8192, DL_WS = 12 * 8192, DL_OUT = 12 * 8192 + 2048;
#define KSW2(row, colB) ((row) * 128 + ((colB) ^ ((((row) >> 1) & 7) << 4)))
__device__ __forceinline__ void dil_compute(const bf16x8 (&qr)[4], const int mdelta, f32x16 (&o)[2], float& m_reg, float& l_reg) {
  LAS unsigned char* lds = (LAS unsigned char*)smem;
  const int tid = otid(), wid = __builtin_amdgcn_readfirstlane(tid >> 6), lane = tid & 63, r32 = lane & 31, hi = lane >> 5;
  LAS float* wsl = (LAS float*)(lds + DL_WS) + wid * 64; LAS float* al_l = wsl + 32;
  m_reg = -30000.f; l_reg = 0.f; o[0] = f32x16{}; o[1] = f32x16{};
  int jlo, jhi;
  { const int a = 32 * wid - 127 - mdelta + 63, b = 32 * wid + 95 - mdelta;
    jlo = a >= 0 ? a / 64 : -((-a + 63) / 64); jhi = b >= 0 ? b / 64 : -((-b + 63) / 64);
    jlo = jlo < 0 ? 0 : jlo; jhi = jhi > 5 ? 5 : jhi; }
  const int vb0 = (int)(unsigned)(uintptr_t)lds + DL_V + v_rd_base(lane);
#pragma unroll 1
  for (int j = jlo; j <= jhi; ++j) {
    f32x16 p0 = f32x16{}, p1 = f32x16{};
    LAS unsigned char* kt = lds + DL_K + j * 8192;
#pragma unroll
    for (int d0 = 0; d0 < 4; ++d0) { const int cb = (d0 * 16 + hi * 8) * 2;
      const bf16x8 b0 = *(const LAS bf16x8*)(kt + KSW2(r32, cb)), b1 = *(const LAS bf16x8*)(kt + KSW2(32 + r32, cb));
      p0 = __builtin_amdgcn_mfma_f32_32x32x16_bf16(b0, qr[d0], p0, 0, 0, 0);
      p1 = __builtin_amdgcn_mfma_f32_32x32x16_bf16(b1, qr[d0], p1, 0, 0, 0); }
    { const int dl = mdelta + j * 64 - (wid * 32 + r32) + 4 * hi;
#pragma unroll
      for (int r = 0; r < 16; ++r) { const int dd = dl + (r & 3) + 8 * (r >> 2);
        if ((unsigned)(dd + 64) > 128u) p0[r] = -1e30f; if ((unsigned)(dd + 96) > 128u) p1[r] = -1e30f; } }
    float mn, alpha; bf16x8 pa0, pa1, pa2, pa3;
    partialSM(p0, p1, m_reg, mn, alpha, LOG2E, 8.f);
    if (__any(alpha < 1.f)) { if (hi == 0) al_l[r32] = alpha; asm volatile("s_waitcnt lgkmcnt(0)" ::: "memory");
#pragma unroll
      for (int d = 0; d < 2; ++d)
#pragma unroll
        for (int r = 0; r < 16; ++r) o[d][r] *= al_l[crow(r, hi)]; }
    finishSM(p0, p1, alpha, l_reg, pa0, pa1, pa2, pa3);
    const int vb = vb0 + j * 8192;
    pv_one<0>(o[0], vb, pa0, pa1, pa2, pa3); pv_one<1>(o[1], vb, pa0, pa1, pa2, pa3);
  }
  if (hi == 0) wsl[r32] = l_reg;
  asm volatile("s_waitcnt lgkmcnt(0)" ::: "memory");
#pragma unroll
  for (int r = 0; r < 16; ++r) { const float rl = __builtin_amdgcn_rcpf(wsl[crow(r, hi)]); o[0][r] *= rl; o[1][r] *= rl; }
}

__device__ __forceinline__ int perm_in(int p) { const int g = p >> 5, n = (p >> 4) & 1, fq = (p >> 2) & 3, j = p & 3; return (g >> 1) * 64 + (g & 1) * 16 + n * 32 + fq * 4 + j; }
__device__ __forceinline__ void prep_store(bf16_t* dst, const float* W, const int ldw, const int sc, const int k0, const int kvalid, const float* g) {
  float v[8];
#pragma unroll
  for (int e = 0; e < 8; ++e) { const int k = k0 + e; float t = 0.f; if (sc >= 0 && k < kvalid) { t = W[(size_t)k * ldw + sc]; if (g) t *= g[k]; } v[e] = t; }
  u32x4 w = {cvtpk(v[0], v[1]), cvtpk(v[2], v[3]), cvtpk(v[4], v[5]), cvtpk(v[6], v[7])};
  *(u32x4*)dst = w;
}
__device__ void phase_prep(const Params& P) {
  unsigned char* ws = P.ws;
  const long gtid = (long)blockIdx.x * NTHREADS + otid(), gsz = (long)GRIDX * NTHREADS;
  for (long it = gtid; it < 8192L * 128; it += gsz) {
    const int n = (int)(it % 8192), k8 = (int)(it / 8192);
    const int t = n >> 8, l = perm_in(n & 255);
    int sc;
    if (t == 0) sc = l;
    else if (t == 1) sc = (l < 128) ? 256 + l : (l < 160 ? 384 + (l - 128) : -1);
    else if (t < 4) sc = 416 + (t - 2) * 256 + l;
    else if (t < 8) sc = 6048 + (t - 4) * 256 + l;
    else if (t < 12) sc = 7072 + (t - 8) * 256 + l;
    else if (t < 18) sc = 928 + (t - 12) * 256 + l;
    else if (t < 24) sc = 2464 + (t - 18) * 256 + l;
    else if (t < 30) sc = 4000 + (t - 24) * 256 + l;
    else sc = 5536 + (t - 30) * 256 + l;
    prep_store((bf16_t*)(ws + WS_WIN) + (size_t)n * 1024 + k8 * 8, P.w_in, INW, sc, k8 * 8, 1024, nullptr);
  }
  for (long it = gtid; it < 1024L * 32; it += gsz) {
    const int n = (int)(it % 1024), k8 = (int)(it / 1024);
    const int t = n >> 8, p = n & 255, gi = p >> 5, nn = (p >> 4) & 1, fq = (p >> 2) & 3, j = p & 3;
    const int head = 2 * t + (gi >> 2), sub = gi & 3;
    int sc;
    if (sub < 2) sc = head * 96 + sub * 32 + nn * 16 + fq * 4 + j;
    else if (sub == 2) sc = head * 96 + 64 + nn * 16 + fq * 4 + j;
    else sc = -1;
    prep_store((bf16_t*)(ws + WS_WUQ) + (size_t)n * 256 + k8 * 8, P.w_uq, 768, sc, k8 * 8, 256, P.gq);
  }
  for (long it = gtid; it < 1024L * 32; it += gsz) {
    const int n = (int)(it % 1024), k8 = (int)(it / 1024);
    prep_store((bf16_t*)(ws + WS_WUKV) + (size_t)n * 256 + k8 * 8, P.w_ukv, 1024, n, k8 * 8, 128, P.gkv);
  }
  for (long it = gtid; it < 1024L * 64; it += gsz) {
    const int n = (int)(it % 1024), k8 = (int)(it / 1024);
    prep_store((bf16_t*)(ws + WS_WOM) + (size_t)n * 512 + k8 * 8, P.w_om, 1024, n, k8 * 8, 512, nullptr);
    prep_store((bf16_t*)(ws + WS_WOD) + (size_t)n * 512 + k8 * 8, P.w_od, 1024, n, k8 * 8, 512, nullptr);
  }
  for (long it = gtid; it < 1024L * 128; it += gsz) {
    const int n = (int)(it % 1024), k8 = (int)(it / 1024);
    prep_store((bf16_t*)(ws + WS_WOUT) + (size_t)n * 1024 + k8 * 8, P.w_out, 1024, n, k8 * 8, 1024, nullptr);
  }
  for (long it = gtid; it < (long)NTOK * 32; it += gsz) {
    const int tok = (int)(it >> 5), i = (int)(it & 31);
    const double ang = (double)P.pos[tok] * (double)P.inv_freq[i];
    double rev = ang * 0.15915494309189535; rev -= floor(rev);
    const float rf = (float)rev;
    ((float*)(ws + WS_COS))[it] = __builtin_amdgcn_cosf(rf);
    ((float*)(ws + WS_SIN))[it] = __builtin_amdgcn_sinf(rf);
  }
  {
    const int lane = otid() & 63; const long wv = gtid >> 6, nwv = gsz >> 6;
    bf16_t* H = (bf16_t*)P.out;
    f32x4 g4[4];
#pragma unroll
    for (int c = 0; c < 4; ++c) g4[c] = *(const f32x4*)(P.attn_g + c * 256 + lane * 4);
    for (long row = wv; row < NTOK; row += nwv) {
      const float* xr = P.x + row * DM; f32x4 v[4]; float ss = 0.f;
#pragma unroll
      for (int c = 0; c < 4; ++c) { v[c] = *(const f32x4*)(xr + c * 256 + lane * 4); ss += v[c][0] * v[c][0] + v[c][1] * v[c][1] + v[c][2] * v[c][2] + v[c][3] * v[c][3]; }
      ss = wave_sum(ss);
      const float rs = rsqrtf(ss * (1.f / DM) + RMS_EPS);
#pragma unroll
      for (int c = 0; c < 4; ++c) { f32x4 t = v[c] * rs * g4[c]; st4bf(H + row * DM + c * 256 + lane * 4, t); }
    }
  }
}

constexpr int STAGGER_TICKS = 0;
template <int MODE>
__device__ void phase_gemm(const Params& P, const bf16_t* A, const bf16_t* Bt, const int K, const int pn_lo, const int npn, const int pnb_lo) {
  const int G = GRIDX, v = vcu_id_(GRIDX), nunits = (NTOK / 256) * npn;
  const bool xl = (G == 256) && ((npn & 3) == 0);
  if constexpr (MODE == M_IN) {
    const int ticks = (v & 7) * STAGGER_TICKS;
    if (ticks > 0) { const unsigned long long t0 = __builtin_amdgcn_s_memrealtime(); while (__builtin_amdgcn_s_memrealtime() - t0 < (unsigned long long)ticks) __builtin_amdgcn_s_sleep(8); }
  }
  const int nr = xl ? (npn >> 1) : (v < nunits ? (nunits - v + G - 1) / G : 0);
#pragma unroll 1
  for (int i = 0; i < nr; ++i) {
    int pm, pl;
    if (xl) { pm = 16 * (v >> 5) + 8 * (i & 1) + (v & 7); pl = 4 * (i >> 1) + ((v & 31) >> 3); }
    else { const int u = v + i * G; pm = u / npn; pl = u - pm * npn; }
    gemm_tile<MODE>(P, A, Bt, K, pm, pnb_lo + pl, pn_lo + pl);
  }
  __syncthreads();
}

struct DilUnit { const bf16_t* Qb; const bf16_t* Kb; const bf16_t* Vb; long ld; int mdelta, b, p0, dil, rho, gh; };
__device__ __forceinline__ DilUnit dil_decode(const Params& P, const int u) {
  const bf16_t* QD = (const bf16_t*)(P.ws + WS_QD); const bf16_t* KD = (const bf16_t*)(P.ws + WS_KD); const bf16_t* VD = (const bf16_t*)(P.ws + WS_VD);
  const int g = u >> 10, rem = u & 1023, b = rem >> 8, h8 = (rem >> 5) & 7, xx = rem & 31;
  const int dil = (g == 0) ? 1 : (g == 1 ? 4 : 16), L = SEQ / dil;
  const int rho = xx % dil, blk = xx / dil, gh = g * 8 + h8, p0 = blk * 256;
  int t0 = p0 / 64 - 1; t0 = t0 < 0 ? 0 : t0; if (t0 > L / 64 - 6) t0 = L / 64 - 6;
  const int k0 = t0 * 64;
  DilUnit U; U.ld = (long)dil * 1536; U.mdelta = k0 - p0; U.b = b; U.p0 = p0; U.dil = dil; U.rho = rho; U.gh = gh;
  U.Qb = QD + ((long)b * SEQ + (long)p0 * dil + rho) * 1536 + gh * 64;
  U.Kb = KD + ((long)b * SEQ + (long)k0 * dil + rho) * 1536 + gh * 64;
  U.Vb = VD + ((long)b * SEQ + (long)k0 * dil + rho) * 1536 + gh * 64;
  return U;
}
__device__ void phase_dilated(const Params& P) {
  unsigned char* ws = P.ws;
  LAS unsigned char* lds = (LAS unsigned char*)smem;
  bf16_t* OG = (bf16_t*)(ws + WS_OG); float* LSE = (float*)(ws + WS_LSE);
  const int tid = otid(), wid = __builtin_amdgcn_readfirstlane(tid >> 6), lane = tid & 63, r32 = lane & 31, hi = lane >> 5;
  const int sr = tid >> 3, sc = (tid & 7) * 8, kst = KSW2(sr, sc * 2), vst = v_st(sr, sc);
  const int G = GRIDX;
  int u = vcu_id_(G);
  if (u >= 3072) return;
  DilUnit U = dil_decode(P, u);
  bf16x8 kk[6], vv[6], qn[4];
#define DIL_LOADS(UU) do { _Pragma("unroll") for (int t = 0; t < 6; ++t) { kk[t] = *(const bf16x8*)((UU).Kb + (long)(t * 64 + sr) * (UU).ld + sc); vv[t] = *(const bf16x8*)((UU).Vb + (long)(t * 64 + sr) * (UU).ld + sc); } \
    _Pragma("unroll") for (int d0 = 0; d0 < 4; ++d0) qn[d0] = *(const bf16x8*)((UU).Qb + (long)(wid * 32 + r32) * (UU).ld + hi * 8 + d0 * 16); } while (0)
  DIL_LOADS(U);
#pragma unroll 1
  for (; u < 3072; u += G) {
    const DilUnit C = U;
    bf16x8 qr[4];
#pragma unroll
    for (int t = 0; t < 6; ++t) { *(LAS bf16x8*)(lds + DL_K + t * 8192 + kst) = kk[t]; *(LAS bf16x8*)(lds + DL_V + t * 8192 + vst) = vv[t]; }
#pragma unroll
    for (int d0 = 0; d0 < 4; ++d0) qr[d0] = qn[d0];
    __syncthreads();
    if (u + G < 3072) { U = dil_decode(P, u + G); DIL_LOADS(U); }
    f32x16 o[2]; float m_reg, l_reg;
    dil_compute(qr, C.mdelta, o, m_reg, l_reg);
    {
      LAS unsigned char* ob = lds + DL_OUT + wid * (32 * 128);
#pragma unroll
      for (int r = 0; r < 16; ++r)
#pragma unroll
        for (int d0 = 0; d0 < 2; ++d0) *(LAS unsigned short*)(ob + crow(r, hi) * 128 + (d0 * 32 + r32) * 2) = (unsigned short)(cvtpk(o[d0][r], 0.f) & 0xffffu);
#pragma unroll
      for (int i = 0; i < 4; ++i) { const int row = (lane >> 3) + 8 * i, ch = lane & 7;
        const u32x4 w = *(const LAS u32x4*)(ob + row * 128 + ch * 16);
        const long tok = (long)C.b * SEQ + (long)(C.p0 + wid * 32 + row) * C.dil + C.rho;
        *(u32x4*)(OG + tok * 1536 + C.gh * 64 + ch * 8) = w; }
    }
    if (hi == 0) { const long tok = (long)C.b * SEQ + (long)(C.p0 + wid * 32 + r32) * C.dil + C.rho; LSE[tok * 24 + C.gh] = m_reg + __logf(l_reg); }
    __syncthreads();
  }
#undef DIL_LOADS
}

__device__ void phase_combine(const Params& P) {
  unsigned char* ws = P.ws;
  const bf16_t* OG = (const bf16_t*)(ws + WS_OG); const float* LSE = (const float*)(ws + WS_LSE); const bf16_t* ZD = (const bf16_t*)(ws + WS_ZD);
  bf16_t* A2 = (bf16_t*)(ws + WS_A2);
  const long gtid = (long)blockIdx.x * NTHREADS + otid(), gsz = (long)GRIDX * NTHREADS;
  for (long it = gtid; it < (long)NTOK * 64; it += gsz) {
    const long tok = it >> 6; const int c8 = (int)(it & 63), hh = c8 >> 3, col = c8 * 8;
    const float l0 = LSE[tok * 24 + hh], l1 = LSE[tok * 24 + 8 + hh], l2 = LSE[tok * 24 + 16 + hh];
    const float mx = fmaxf(l0, fmaxf(l1, l2));
    float w0 = __expf(l0 - mx), w1 = __expf(l1 - mx), w2 = __expf(l2 - mx);
    const float inv = 1.f / (w0 + w1 + w2); w0 *= inv; w1 *= inv; w2 *= inv;
    const u32x4 a = *(const u32x4*)(OG + tok * 1536 + col), bq = *(const u32x4*)(OG + tok * 1536 + 512 + col), c = *(const u32x4*)(OG + tok * 1536 + 1024 + col);
    const u32x4 z = *(const u32x4*)(ZD + tok * 512 + col);
    u32x4 r;
#pragma unroll
    for (int e = 0; e < 4; ++e) {
      const float lo = (w0 * bflo(a[e]) + w1 * bflo(bq[e]) + w2 * bflo(c[e])) * bflo(z[e]);
      const float hi_ = (w0 * bfhi(a[e]) + w1 * bfhi(bq[e]) + w2 * bfhi(c[e])) * bfhi(z[e]);
      r[e] = cvtpk(lo, hi_);
    }
    *(u32x4*)(A2 + tok * 512 + col) = r;
  }
}

__device__ void phase_kpe(const Params& P) {
  unsigned char* ws = P.ws;
  const bf16_t* CKVR = (const bf16_t*)(ws + WS_CKVR); bf16_t* MK = (bf16_t*)(ws + WS_MK);
  const float* cosT = (const float*)(ws + WS_COS); const float* sinT = (const float*)(ws + WS_SIN);
  const long gtid = (long)blockIdx.x * NTHREADS + otid(), gsz = (long)GRIDX * NTHREADS;
  for (long it = gtid; it < (long)NTOK * 4; it += gsz) {
    const long tok = it >> 2; const int hq = (int)(it & 3);
    const u32x4 r0 = *(const u32x4*)(CKVR + tok * 256 + 128), r1 = *(const u32x4*)(CKVR + tok * 256 + 136),
                r2 = *(const u32x4*)(CKVR + tok * 256 + 144), r3 = *(const u32x4*)(CKVR + tok * 256 + 152);
    float a[16], bb[16];
#pragma unroll
    for (int e = 0; e < 4; ++e) { a[2 * e] = bflo(r0[e]); a[2 * e + 1] = bfhi(r0[e]); a[8 + 2 * e] = bflo(r1[e]); a[8 + 2 * e + 1] = bfhi(r1[e]);
                                  bb[2 * e] = bflo(r2[e]); bb[2 * e + 1] = bfhi(r2[e]); bb[8 + 2 * e] = bflo(r3[e]); bb[8 + 2 * e + 1] = bfhi(r3[e]); }
    float o1[16], o2[16];
#pragma unroll
    for (int q = 0; q < 8; ++q) {
      const f32x4 c4 = *(const f32x4*)(cosT + tok * 32 + 4 * q), s4 = *(const f32x4*)(sinT + tok * 32 + 4 * q);
      o1[2 * q] = a[2 * q] * c4[0] - bb[2 * q] * s4[0];             o2[2 * q] = bb[2 * q] * c4[0] + a[2 * q] * s4[0];
      o1[2 * q + 1] = a[2 * q + 1] * c4[2] - bb[2 * q + 1] * s4[2]; o2[2 * q + 1] = bb[2 * q + 1] * c4[2] + a[2 * q + 1] * s4[2];
    }
    u32x4 w0, w1, w2, w3;
#pragma unroll
    for (int e = 0; e < 4; ++e) { w0[e] = cvtpk(o1[2 * e], o1[2 * e + 1]); w1[e] = cvtpk(o1[8 + 2 * e], o1[8 + 2 * e + 1]);
                                  w2[e] = cvtpk(o2[2 * e], o2[2 * e + 1]); w3[e] = cvtpk(o2[8 + 2 * e], o2[8 + 2 * e + 1]); }
    const long b = tok / SEQ, s_ = tok % SEQ;
#pragma unroll
    for (int hh = 0; hh < 2; ++hh) { bf16_t* kr = MK + ((b * 8 + hq * 2 + hh) * SEQ + s_) * 96 + 64;
      *(u32x4*)(kr) = w0; *(u32x4*)(kr + 8) = w1; *(u32x4*)(kr + 16) = w2; *(u32x4*)(kr + 24) = w3; }
  }
}

__device__ void phase_mla(const Params& P) {
  unsigned char* ws = P.ws;
  const bf16_t* MQ = (const bf16_t*)(ws + WS_MQ); const bf16_t* MK = (const bf16_t*)(ws + WS_MK); const bf16_t* MV = (const bf16_t*)(ws + WS_MV);
  const bf16_t* ZM = (const bf16_t*)(ws + WS_ZM); bf16_t* A1 = (bf16_t*)(ws + WS_A1);
  const int tid = otid(), wid = tid >> 6, lane = tid & 63, r32 = lane & 31, hi = lane >> 5;
  const float scale = 0.10206207261596577f;
  const int G = GRIDX;
  for (int u0 = blockIdx.x; u0 < 1024; u0 += G) {
    int u = u0;
    if (G == 256) { const int i = u0 >> 8, bx = u0 & 255; u = (i * 8 + (bx & 7)) * 32 + (bx >> 3); }
    const int bh = u >> 5, qb = u & 31, b = bh >> 3, h = bh & 7;
    const bf16_t* Qb = MQ + ((long)bh * SEQ + qb * 256) * 96;
    f32x16 o[2]; float m_reg, l_reg;
    attn_body<6, false>(Qb, 96, MK + (long)bh * SEQ * 96, 96, MV + (long)bh * SEQ * 64, 64, SEQ / 64, scale * LOG2E, 8.f / scale, 0, o, m_reg, l_reg);
    {
      LAS unsigned char* ob = (LAS unsigned char*)smem + AT_WSOFF + 2048 + wid * 4096;
#pragma unroll
      for (int r = 0; r < 16; ++r)
#pragma unroll
        for (int d0 = 0; d0 < 2; ++d0) *(LAS unsigned short*)(ob + crow(r, hi) * 128 + (d0 * 32 + r32) * 2) = (unsigned short)(cvtpk(o[d0][r], 0.f) & 0xffffu);
#pragma unroll
      for (int i = 0; i < 4; ++i) { const int row = (lane >> 3) + 8 * i, ch = lane & 7;
        const u32x4 w = *(const LAS u32x4*)(ob + row * 128 + ch * 16);
        const long idx = ((long)b * SEQ + qb * 256 + wid * 32 + row) * 512 + h * 64 + ch * 8;
        const u32x4 z = *(const u32x4*)(ZM + idx);
        u32x4 rr;
#pragma unroll
        for (int e = 0; e < 4; ++e) rr[e] = cvtpk(bflo(w[e]) * bflo(z[e]), bfhi(w[e]) * bfhi(z[e]));
        *(u32x4*)(A1 + idx) = rr; }
    }
    __syncthreads();
  }
}

__device__ void phase_final_norm(const Params& P) {
  const long gtid = (long)blockIdx.x * NTHREADS + otid(), gsz = (long)GRIDX * NTHREADS;
  const int lane = otid() & 63; const long wv = gtid >> 6, nwv = gsz >> 6;
  f32x4 g4[4];
#pragma unroll
  for (int c = 0; c < 4; ++c) g4[c] = *(const f32x4*)(P.final_g + c * 256 + lane * 4);
  for (long row = wv; row < NTOK; row += nwv) {
    const float* xr = (const float*)(P.ws + WS_PRE) + row * DM; float* orow = P.out + row * DM; f32x4 v[4]; float ss = 0.f;
#pragma unroll
    for (int c = 0; c < 4; ++c) { v[c] = *(const f32x4*)(xr + c * 256 + lane * 4); ss += v[c][0] * v[c][0] + v[c][1] * v[c][1] + v[c][2] * v[c][2] + v[c][3] * v[c][3]; }
    ss = wave_sum(ss);
    const float rs = rsqrtf(ss * (1.f / DM) + RMS_EPS);
#pragma unroll
    for (int c = 0; c < 4; ++c) *(f32x4*)(orow + c * 256 + lane * 4) = v[c] * rs * g4[c];
  }
}

__device__ __forceinline__ void fast_barrier(unsigned* ctr, const unsigned epoch, const unsigned ngrid) {
  asm volatile("s_waitcnt vmcnt(0)" ::: "memory");
  __syncthreads();
  if (threadIdx.x == 0) {
    __builtin_amdgcn_fence(__ATOMIC_RELEASE, "agent");
    asm volatile("s_waitcnt vmcnt(0)" ::: "memory");
    const unsigned target = epoch * ngrid;
    (void)__hip_atomic_fetch_add(ctr, 1u, __ATOMIC_RELAXED, __HIP_MEMORY_SCOPE_AGENT);
    while (__hip_atomic_load(ctr, __ATOMIC_RELAXED, __HIP_MEMORY_SCOPE_AGENT) < target) __builtin_amdgcn_s_sleep(1);
    __builtin_amdgcn_fence(__ATOMIC_ACQUIRE, "agent");
    asm volatile("s_waitcnt vmcnt(0)" ::: "memory");
  }
  __syncthreads();
}
#define XB_XCNT(j)  (64 * (j))
#define XB_XSUB(j)  (1024 + 64 * (j))
#define XB_XGEN(j)  (2048 + 64 * (j))
#define XB_TOP      3072
#define XB_TOPGEN   3136
constexpr int XB_WORDS = 3200;
constexpr int LDS_XB = LDS_BYTES - 16;
__device__ __forceinline__ unsigned xb_ld(unsigned* p)              { return __hip_atomic_load(p, __ATOMIC_RELAXED, __HIP_MEMORY_SCOPE_AGENT); }
__device__ __forceinline__ unsigned xb_add(unsigned* p, unsigned v) { return __hip_atomic_fetch_add(p, v, __ATOMIC_RELAXED, __HIP_MEMORY_SCOPE_AGENT); }
__device__ __forceinline__ unsigned xb_xcc_id() { return (unsigned)__builtin_amdgcn_s_getreg((3 << 11) | 20) & 0xFu; }
__device__ __forceinline__ void xcd_barrier(unsigned* bar, const unsigned ngrid) {
  asm volatile("s_waitcnt vmcnt(0)" ::: "memory");
  __syncthreads();
  if (threadIdx.x == 0) {
    volatile LAS unsigned* st = (volatile LAS unsigned*)((LAS unsigned char*)smem + LDS_XB);
    const unsigned x = xb_xcc_id();
    unsigned nloc = st[0], nx = st[1];
    if (nloc == 0u) {
      for (;;) { unsigned sum = 0u, cnt = 0u, mine = 0u;
#pragma unroll
        for (unsigned j = 0; j < 16; ++j) { const unsigned c = xb_ld(&bar[XB_XCNT(j)]); sum += c; cnt += (c > 0u) ? 1u : 0u; mine = (j == x) ? c : mine; }
        if (sum == ngrid) { nloc = mine; nx = cnt; break; }
        __builtin_amdgcn_s_sleep(1); }
      st[0] = nloc; st[1] = nx;
    }
    const unsigned old = xb_add(&bar[XB_XSUB(x)], 1u);
    const unsigned gen = old / nloc;
    if (old + 1u == (gen + 1u) * nloc) {
      __builtin_amdgcn_fence(__ATOMIC_RELEASE, "agent");
      asm volatile("s_waitcnt vmcnt(0)" ::: "memory");
      const unsigned og = xb_add(&bar[XB_TOP], 1u);
      const unsigned tg = og / nx;
      if (og + 1u == (tg + 1u) * nx) xb_add(&bar[XB_TOPGEN], 1u);
      else while (xb_ld(&bar[XB_TOPGEN]) == tg) __builtin_amdgcn_s_sleep(1);
      __builtin_amdgcn_fence(__ATOMIC_ACQUIRE, "agent");
      xb_add(&bar[XB_XGEN(x)], 1u);
      asm volatile("s_waitcnt vmcnt(0)" ::: "memory");
    } else {
      while (xb_ld(&bar[XB_XGEN(x)]) == gen) __builtin_amdgcn_s_sleep(1);
      __builtin_amdgcn_fence(__ATOMIC_ACQUIRE, "agent");
      asm volatile("s_waitcnt vmcnt(0)" ::: "memory");
    }
  }
  __syncthreads();
}
constexpr int N_PHASES = 11;
template <int PH>
__device__ __forceinline__ void run_phase(const Params& P) {
  unsigned char* ws = P.ws;
  const bf16_t* H = (const bf16_t*)P.out;
  if constexpr (PH == 0) phase_prep(P);
  else if constexpr (PH == 1) phase_gemm<M_IN>(P, H, (const bf16_t*)(ws + WS_WIN), 1024, 12, 20, 12);
  else if constexpr (PH == 2) phase_dilated(P);
  else if constexpr (PH == 3) phase_combine(P);
  else if constexpr (PH == 4) phase_gemm<M_IN>(P, H, (const bf16_t*)(ws + WS_WIN), 1024, 0, 12, 0);
  else if constexpr (PH == 5) {
    phase_gemm<M_UQ>(P, (const bf16_t*)(ws + WS_CQ), (const bf16_t*)(ws + WS_WUQ), 256, 0, 4, 0);
    phase_gemm<M_UKV>(P, (const bf16_t*)(ws + WS_CKVR), (const bf16_t*)(ws + WS_WUKV), 256, 0, 4, 0);
    phase_kpe(P);
  }
  else if constexpr (PH == 6) phase_mla(P);
  else if constexpr (PH == 7) phase_gemm<M_OUT1>(P, (const bf16_t*)(ws + WS_A1), (const bf16_t*)(ws + WS_WOM), 512, 0, 4, 0);
  else if constexpr (PH == 8) phase_gemm<M_OUT2>(P, (const bf16_t*)(ws + WS_A2), (const bf16_t*)(ws + WS_WOD), 512, 0, 4, 0);
  else if constexpr (PH == 9) phase_gemm<M_FINAL>(P, (const bf16_t*)(ws + WS_MERGED), (const bf16_t*)(ws + WS_WOUT), 1024, 0, 4, 0);
  else phase_final_norm(P);
}

#if defined(__HIP_DEVICE_COMPILE__)
__device__ __forceinline__ Params load_params() {
  auto kp = __builtin_amdgcn_kernarg_segment_ptr();
  asm volatile("" : "+s"(kp));
  return *(const __attribute__((address_space(4))) Params*)kp;
}
#else
__device__ __forceinline__ Params load_params() { return Params{}; }
#endif
#if N_LAUNCH_PER_PHASE
template <int PH>
__global__ void __launch_bounds__(NTHREADS) k_phase(Params P) { run_phase<PH>(P); }
#else
__global__ void __launch_bounds__(NTHREADS) k_mega(Params P) {
  cg::grid_group grid = cg::this_grid();
  if (P.ws == nullptr) grid.sync();
#define SEAM(e)  do { const Params Q = load_params(); xcd_barrier((unsigned*)((unsigned char*)Q.out + OUT_BAR_OFF), (unsigned)Q.ngrid); } while (0)
  if (threadIdx.x == 0) { volatile LAS unsigned* st = (volatile LAS unsigned*)((LAS unsigned char*)smem + LDS_XB); st[0] = 0u; st[1] = 0u;
    (void)xb_add((unsigned*)((unsigned char*)P.out + OUT_BAR_OFF) + XB_XCNT(xb_xcc_id()), 1u); }
  __syncthreads();
#define SEAMB(e) do { const Params Q = load_params(); xcd_barrier((unsigned*)(Q.ws + WS_COS), (unsigned)Q.ngrid); } while (0)
#define RUN(k)   do { const Params Q = load_params(); run_phase<k>(Q); } while (0)
  run_phase<0>(P); SEAM(1);
  RUN(1); SEAM(2);
  RUN(2); SEAM(3);
  RUN(3); SEAM(4);
  RUN(4); SEAM(5);
  RUN(5); SEAM(6);
  if (blockIdx.x == 0) { const Params Q = load_params(); const int t = otid();
    for (int w = t; w < XB_WORDS; w += NTHREADS) __hip_atomic_store((unsigned*)(Q.ws + WS_COS) + w, 0u, __ATOMIC_RELAXED, __HIP_MEMORY_SCOPE_AGENT);
    if (t < 128) __hip_atomic_store((unsigned*)(Q.ws + WS_SIN) + t, 0u, __ATOMIC_RELAXED, __HIP_MEMORY_SCOPE_AGENT); }
  RUN(6); SEAM(7);
  { const Params Q = load_params();
    phase_gemm<M_OUT12>(Q, (const bf16_t*)(Q.ws + WS_A1), (const bf16_t*)(Q.ws + WS_WOM), 512, 0, 4, 0); }
  SEAMB(1);
  { const Params Q = load_params();
    phase_gemm<M_FINALN>(Q, (const bf16_t*)(Q.ws + WS_MERGED), (const bf16_t*)(Q.ws + WS_WOUT), 1024, 0, 4, 0); }
}
#endif

template <int PH> static void launch_phase(const Params& p, int grid, hipStream_t stream) {
#if N_LAUNCH_PER_PHASE
  static bool attr = false;
  if (!attr) { (void)hipFuncSetAttribute((const void*)k_phase<PH>, hipFuncAttributeMaxDynamicSharedMemorySize, LDS_BYTES); attr = true; }
  hipLaunchKernelGGL(k_phase<PH>, dim3(grid), dim3(NTHREADS), LDS_BYTES, stream, p);
#endif
}

extern "C" void kernel_launch(void* const* d_in, const int* in_sizes, int n_in, void* d_out, int out_size, void* d_ws, size_t ws_size, hipStream_t stream) {
  static int grid = 0;
  if (grid == 0) {
    if (n_in != 13 || in_sizes[0] != NTOK * DM || out_size != NTOK * DM || ws_size < WS_END) {
      fprintf(stderr, "kernel_launch: unexpected shapes (n_in %d, in0 %d, out %d, ws %zu)\n", n_in, n_in > 0 ? in_sizes[0] : -1, out_size, ws_size); grid = -1; return; }
    int dev = 0, cus = 0;
    (void)hipGetDevice(&dev); (void)hipDeviceGetAttribute(&cus, hipDeviceAttributeMultiprocessorCount, dev);
#if N_LAUNCH_PER_PHASE
    grid = cus > 0 ? cus : 256;
#else
    int per_cu = 0;
    if (hipFuncSetAttribute((const void*)k_mega, hipFuncAttributeMaxDynamicSharedMemorySize, LDS_BYTES) != hipSuccess) { fprintf(stderr, "kernel_launch: hipFuncSetAttribute failed\n"); grid = -1; return; }
    if (hipOccupancyMaxActiveBlocksPerMultiprocessor(&per_cu, (const void*)k_mega, NTHREADS, LDS_BYTES) != hipSuccess || per_cu < 1) { fprintf(stderr, "kernel_launch: occupancy query failed (%d)\n", per_cu); grid = -1; return; }
    grid = cus;
    if (grid % 4 != 0) { fprintf(stderr, "kernel_launch: %d CUs: the fused final-norm exchange needs a grid that is a multiple of 4\n", grid); grid = -1; return; }
#endif
  }
  if (grid < 0) return;
  Params p{};
  p.x = (const float*)d_in[0]; p.pos = (const int*)d_in[1]; p.attn_g = (const float*)d_in[2]; p.w_in = (const float*)d_in[3]; p.b_gate = (const float*)d_in[4];
  p.gq = (const float*)d_in[5]; p.gkv = (const float*)d_in[6]; p.w_uq = (const float*)d_in[7]; p.w_ukv = (const float*)d_in[8]; p.w_om = (const float*)d_in[9];
  p.w_od = (const float*)d_in[10]; p.w_out = (const float*)d_in[11]; p.final_g = (const float*)d_in[12];
  p.out = (float*)d_out; p.ws = (unsigned char*)d_ws;
  for (int i = 0; i < 32; ++i) p.inv_freq[i] = powf(10000.0f, -(float)(2 * i) / 64.0f);
  p.ngrid = grid;
#if N_LAUNCH_PER_PHASE
  launch_phase<0>(p, grid, stream); launch_phase<1>(p, grid, stream); launch_phase<2>(p, grid, stream); launch_phase<3>(p, grid, stream);
  launch_phase<4>(p, grid, stream); launch_phase<5>(p, grid, stream); launch_phase<6>(p, grid, stream); launch_phase<7>(p, grid, stream);
  launch_phase<8>(p, grid, stream); launch_phase<9>(p, grid, stream); launch_phase<10>(p, grid, stream);
#else
  (void)hipMemsetAsync((unsigned char*)d_out + OUT_BAR_OFF, 0, XB_WORDS * 4, stream);
  void* args[] = {&p};
  hipError_t e = hipLaunchCooperativeKernel((const void*)k_mega, dim3(grid), dim3(NTHREADS), args, LDS_BYTES, stream);
  if (e != hipSuccess) fprintf(stderr, "cooperative launch failed: %s (grid %d)\n", hipGetErrorString(e), grid);
#endif
}
```

```cpp
#include <hip/hip_runtime.h>
#include <hip/hip_cooperative_groups.h>
#include <cstdio>
#include <cstdint>
#include <cmath>
namespace cg = cooperative_groups;

#ifndef N_LAUNCH_PER_PHASE
#define N_LAUNCH_PER_PHASE 0
#endif

#define LAS __attribute__((address_space(3)))
typedef unsigned short bf16_t;
using bf16x8 = __attribute__((ext_vector_type(8))) short;
using s16x4  = __attribute__((ext_vector_type(4))) short;
using f32x4  = __attribute__((ext_vector_type(4))) float;
using f32x16 = __attribute__((ext_vector_type(16))) float;
using u32x4  = __attribute__((ext_vector_type(4))) unsigned;
using u32x2  = __attribute__((ext_vector_type(2))) unsigned;

constexpr int SEQ = 8192, NBATCH = 4, DM = 1024, NTOK = NBATCH * SEQ, INW = 8096;
constexpr int NTHREADS = 512;
constexpr float RMS_EPS = 1e-6f;
constexpr float LOG2E = 1.4426950408889634f;
constexpr size_t MiB = 1ull << 20;
constexpr size_t WS_WIN = 0, WS_WUQ = 16 * MiB, WS_WUKV = WS_WUQ + MiB / 2, WS_WOM = 17 * MiB, WS_WOD = 18 * MiB, WS_WOUT = 19 * MiB,
                 WS_LSE = 21 * MiB, WS_COS = 24 * MiB, WS_SIN = 28 * MiB, WS_ZD = 32 * MiB, WS_A2 = 64 * MiB, WS_A1 = 96 * MiB,
                 WS_QD = 128 * MiB, WS_KD = 224 * MiB, WS_VD = 320 * MiB, WS_OG = 416 * MiB, WS_END = 512 * MiB,
                 WS_CQ = 128 * MiB, WS_CKVR = 144 * MiB, WS_ZM = 160 * MiB, WS_MQ = 192 * MiB, WS_MK = 240 * MiB, WS_MV = 288 * MiB,
                 WS_GM = 320 * MiB, WS_GD = 384 * MiB, WS_MERGED = 128 * MiB, WS_PRE = 192 * MiB;
constexpr size_t OUT_BAR_OFF = 64 * MiB;
constexpr int EPI_ROWB = 520;
constexpr int LDS_MISC = 256 * EPI_ROWB;
constexpr int LDS_BYTES = LDS_MISC + 2048;

struct Params {
  const float* x; const int* pos; const float* attn_g; const float* w_in; const float* b_gate; const float* gq; const float* gkv;
  const float* w_uq; const float* w_ukv; const float* w_om; const float* w_od; const float* w_out; const float* final_g;
  float* out; unsigned char* ws;
  float inv_freq[32];
  int ngrid; int pad_;
};

extern __shared__ __attribute__((aligned(16))) unsigned char smem[];

#define LOG2E_F 1.4426950408889634f
__device__ __forceinline__ unsigned cvtpk(float lo, float hi) {
  typedef float f32x2_t __attribute__((ext_vector_type(2))); typedef __bf16 bf16x2_t __attribute__((ext_vector_type(2)));
  const f32x2_t v = {lo, hi}; const bf16x2_t r = __builtin_convertvector(v, bf16x2_t); return __builtin_bit_cast(unsigned, r);
}
__device__ __forceinline__ void st16_wt(void* p, u32x4 v) { asm volatile("global_store_dwordx4 %0, %1, off sc1\n\ts_nop 1" :: "v"(p), "v"(v) : "memory"); }
__device__ __forceinline__ float bf2f(unsigned short v) { return __uint_as_float(((unsigned)v) << 16); }
__device__ __forceinline__ float bflo(unsigned w) { return __uint_as_float(w << 16); }
__device__ __forceinline__ float bfhi(unsigned w) { return __uint_as_float(w & 0xffff0000u); }
__device__ __forceinline__ float sigmoidf_(float v) { return __builtin_amdgcn_rcpf(1.f + __builtin_amdgcn_exp2f(-LOG2E_F * v)); }
__device__ __forceinline__ float wave_sum(float v) {
#pragma unroll
  for (int o = 32; o > 0; o >>= 1) v += __shfl_xor(v, o);
  return v;
}
__device__ __forceinline__ int otid() { int t = threadIdx.x; asm volatile("" : "+v"(t)); return t; }
#define GRIDX (P.ngrid)
__device__ __forceinline__ int vcu_id_(const int G) { const int bx = blockIdx.x; return (G % 8 == 0) ? (bx % 8) * (G / 8) + bx / 8 : bx; }

constexpr int BK = 64, HTB = 128 * BK * 2;
__device__ __forceinline__ int lds_byte(int r, int c) {
  int st = (r >> 4) * 2 + (c >> 5), rr = r & 15, cc = c & 31, ob = rr * 64 + cc * 2;
  return st * 1024 + (ob ^ (((ob >> 9) & 1) << 5));
}
__device__ __forceinline__ void stage_rc(int b, int& R, int& C) {
  int st = b / 1024, sb = b % 1024, swz = sb ^ (((sb >> 9) & 1) << 5);
  R = (st >> 1) * 16 + swz / 64; C = (st & 1) * 32 + (swz % 64) / 2;
}

enum { M_IN = 0, M_UQ = 1, M_UKV = 2, M_OUT1 = 3, M_OUT2 = 4, M_FINAL = 5, M_FINALN = 6, M_OUT12 = 7 };

__device__ __forceinline__ void st4bf(bf16_t* p, f32x4 v) { u32x2 w; w.x = cvtpk(v[0], v[1]); w.y = cvtpk(v[2], v[3]); *(u32x2*)p = w; }

template <int TYPE>
__device__ __forceinline__ void epi_in(const Params& P, const f32x4 (&acc)[2][2][4][2], bf16_t* dst, const int ld, const int col0, const float* bias, const float qs,
                                       const int pm, const int wr, const int wc, const int fr, const int fq) {
  LAS unsigned char* lds = (LAS unsigned char*)smem;
  const float* cosT = (const float*)(P.ws + WS_COS); const float* sinT = (const float*)(P.ws + WS_SIN);
  const int fi = (wc & 1) * 16 + fq * 4;
  f32x4 csA[4], snA[4], bbA[2][2];
  if constexpr (TYPE == 2) {
#pragma unroll
    for (int bj = 0; bj < 2; ++bj) { const int lc = (bj * 2 + (wc >> 1)) * 64 + fi; bbA[bj][0] = *(const f32x4*)(bias + lc); bbA[bj][1] = *(const f32x4*)(bias + lc + 32); }
  }
#pragma unroll
  for (int ai = 0; ai < 2; ++ai) {
    if constexpr (TYPE == 3) {
#pragma unroll
      for (int m = 0; m < 4; ++m) { const size_t row = (size_t)(pm * 256 + ai * 128 + wr * 64 + m * 16 + fr);
        csA[m] = *(const f32x4*)(cosT + row * 32 + fi); snA[m] = *(const f32x4*)(sinT + row * 32 + fi); }
    }
#pragma unroll
    for (int m = 0; m < 4; ++m) {
      const int lr = ai * 128 + wr * 64 + m * 16 + fr;
      f32x4 cs = {1.f, 1.f, 1.f, 1.f}, sn = {0.f, 0.f, 0.f, 0.f};
      if constexpr (TYPE == 3) { cs = csA[m]; sn = snA[m]; }
#pragma unroll
      for (int bj = 0; bj < 2; ++bj) {
        const int lc = (bj * 2 + (wc >> 1)) * 64 + fi;
        f32x4 v0 = acc[ai][bj][m][0], v1 = acc[ai][bj][m][1];
        if constexpr (TYPE == 1) {
#pragma unroll
          for (int j = 0; j < 4; ++j) { v0[j] = v0[j] * sigmoidf_(v0[j]); v1[j] = v1[j] * sigmoidf_(v1[j]); }
        } else if constexpr (TYPE == 2) {
          const f32x4 b0 = bbA[bj][0], b1 = bbA[bj][1];
#pragma unroll
          for (int j = 0; j < 4; ++j) { v0[j] = sigmoidf_(v0[j] + b0[j]); v1[j] = sigmoidf_(v1[j] + b1[j]); }
        } else if constexpr (TYPE == 3) {
#pragma unroll
          for (int j = 0; j < 4; ++j) { const float a = v0[j], b = v1[j]; v0[j] = (a * cs[j] - b * sn[j]) * qs; v1[j] = (b * cs[j] + a * sn[j]) * qs; }
        }
        u32x2 w0, w1; w0.x = cvtpk(v0[0], v0[1]); w0.y = cvtpk(v0[2], v0[3]); w1.x = cvtpk(v1[0], v1[1]); w1.y = cvtpk(v1[2], v1[3]);
        *(LAS u32x2*)(lds + lr * EPI_ROWB + lc * 2) = w0;
        *(LAS u32x2*)(lds + lr * EPI_ROWB + lc * 2 + 64) = w1;
      }
    }
  }
  __syncthreads();
  const int t = otid();
  bf16_t* drow = dst + (size_t)pm * 256 * ld + col0;
#pragma unroll 4
  for (int i = 0; i < 16; ++i) {
    const int ch = t + 512 * i, r = ch >> 5, cc = ch & 31;
    const u32x2 a = *(const LAS u32x2*)(lds + r * EPI_ROWB + cc * 16), b = *(const LAS u32x2*)(lds + r * EPI_ROWB + cc * 16 + 8);
    u32x4 w = {a.x, a.y, b.x, b.y};
    st16_wt(drow + (size_t)r * ld + cc * 8, w);
  }
}

template <int MODE>
__device__ __forceinline__ void gemm_epilogue(const Params& P, f32x4 (&acc)[2][2][4][2], const int pm, const int pn, const int wr, const int wc, const int fr, const int fq) {
  unsigned char* ws = P.ws;
  const int row0 = pm * 256 + wr * 64 + fr;
  if constexpr (MODE == M_IN) {
    if (pn == 0)      epi_in<0>(P, acc, (bf16_t*)(ws + WS_CQ),   256,  0,               nullptr, 1.f, pm, wr, wc, fr, fq);
    else if (pn == 1) epi_in<0>(P, acc, (bf16_t*)(ws + WS_CKVR), 256,  0,               nullptr, 1.f, pm, wr, wc, fr, fq);
    else if (pn < 4)  epi_in<1>(P, acc, (bf16_t*)(ws + WS_ZM),   512,  (pn - 2) * 256,  nullptr, 1.f, pm, wr, wc, fr, fq);
    else if (pn < 8)  epi_in<2>(P, acc, (bf16_t*)(ws + WS_GM),   1024, (pn - 4) * 256,  P.b_gate + (pn - 4) * 256, 1.f, pm, wr, wc, fr, fq);
    else if (pn < 12) epi_in<2>(P, acc, (bf16_t*)(ws + WS_GD),   1024, (pn - 8) * 256,  P.b_gate + 1024 + (pn - 8) * 256, 1.f, pm, wr, wc, fr, fq);
    else if (pn < 18) epi_in<3>(P, acc, (bf16_t*)(ws + WS_QD),   1536, (pn - 12) * 256, nullptr, 0.125f, pm, wr, wc, fr, fq);
    else if (pn < 24) epi_in<3>(P, acc, (bf16_t*)(ws + WS_KD),   1536, (pn - 18) * 256, nullptr, 1.f, pm, wr, wc, fr, fq);
    else if (pn < 30) epi_in<0>(P, acc, (bf16_t*)(ws + WS_VD),   1536, (pn - 24) * 256, nullptr, 1.f, pm, wr, wc, fr, fq);
    else              epi_in<1>(P, acc, (bf16_t*)(ws + WS_ZD),   512,  (pn - 30) * 256, nullptr, 1.f, pm, wr, wc, fr, fq);
  } else if constexpr (MODE == M_UQ || MODE == M_UKV) {
    const LAS float* rstd = (const LAS float*)((LAS unsigned char*)smem + LDS_MISC);
    LAS unsigned char* ldsE = (LAS unsigned char*)smem;
    const float* cosT = (const float*)(ws + WS_COS); const float* sinT = (const float*)(ws + WS_SIN);
    bf16_t* MQ = (bf16_t*)(ws + WS_MQ); bf16_t* MK = (bf16_t*)(ws + WS_MK); bf16_t* MV = (bf16_t*)(ws + WS_MV);
    f32x4 cA[4][2], sA[4][2];
#pragma unroll
    for (int ai = 0; ai < 2; ++ai) {
      if constexpr (MODE == M_UQ) { if (wc == 2) {
#pragma unroll
        for (int m = 0; m < 4; ++m) { const size_t row = (size_t)(pm * 256 + ai * 128 + wr * 64 + m * 16 + fr);
          cA[m][0] = *(const f32x4*)(cosT + row * 32 + fq * 8); cA[m][1] = *(const f32x4*)(cosT + row * 32 + fq * 8 + 4);
          sA[m][0] = *(const f32x4*)(sinT + row * 32 + fq * 8); sA[m][1] = *(const f32x4*)(sinT + row * 32 + fq * 8 + 4); }
      } }
#pragma unroll
      for (int m = 0; m < 4; ++m) {
        const int lr = ai * 128 + wr * 64 + m * 16 + fr;
        const int row = pm * 256 + lr;
        const int b = row / SEQ, s = row % SEQ;
        const float rs = rstd[lr];
#pragma unroll
        for (int bj = 0; bj < 2; ++bj) {
          const int head = 2 * pn + bj;
          f32x4 v0 = acc[ai][bj][m][0] * rs, v1 = acc[ai][bj][m][1] * rs;
          const size_t hrow = (size_t)(b * 8 + head) * SEQ + s;
          (void)hrow;
          if constexpr (MODE == M_UQ) { if (wc == 2) {
#pragma unroll
              for (int j = 0; j < 4; ++j) {
                const float c = cA[m][j >> 1][(j & 1) * 2], sn = sA[m][j >> 1][(j & 1) * 2];
                const float a = v0[j], bb = v1[j]; v0[j] = a * c - bb * sn; v1[j] = bb * c + a * sn;
              } } }
          if (MODE == M_UKV || wc < 3) {
            u32x2 w0, w1; w0.x = cvtpk(v0[0], v0[1]); w0.y = cvtpk(v0[2], v0[3]); w1.x = cvtpk(v1[0], v1[1]); w1.y = cvtpk(v1[2], v1[3]);
            const int ic = bj * 128 + wc * 32 + fq * 4;
            *(LAS u32x2*)(ldsE + lr * EPI_ROWB + ic * 2) = w0; *(LAS u32x2*)(ldsE + lr * EPI_ROWB + ic * 2 + 32) = w1;
          }
        }
      }
    }
    __syncthreads();
    {
      const int t = otid();
      const int b = (pm * 256) / SEQ, s0 = (pm * 256) % SEQ;
      constexpr int CPR = (MODE == M_UQ) ? 24 : 32;
#pragma unroll 4
      for (int i = 0; i < CPR / 2; ++i) {
        const int ch = t + 512 * i, r = ch / CPR, c = ch % CPR;
        int hh, icol; bf16_t* dst;
        if constexpr (MODE == M_UQ) { hh = c / 12; const int cc = c % 12; icol = hh * 128 + cc * 8; dst = MQ + ((size_t)(b * 8 + 2 * pn + hh) * SEQ + s0 + r) * 96 + cc * 8; }
        else { hh = c >> 4; const int cc = c & 15; icol = hh * 128 + cc * 8;
          dst = (cc < 8) ? MK + ((size_t)(b * 8 + 2 * pn + hh) * SEQ + s0 + r) * 96 + cc * 8 : MV + ((size_t)(b * 8 + 2 * pn + hh) * SEQ + s0 + r) * 64 + (cc - 8) * 8; }
        const u32x2 a = *(const LAS u32x2*)(ldsE + r * EPI_ROWB + icol * 2), bq = *(const LAS u32x2*)(ldsE + r * EPI_ROWB + icol * 2 + 8);
        *(u32x4*)dst = (u32x4){a.x, a.y, bq.x, bq.y};
      }
    }
  } else if constexpr (MODE == M_OUT1 || MODE == M_OUT2) {
    const bf16_t* G = (const bf16_t*)(ws + (MODE == M_OUT1 ? WS_GM : WS_GD));
    bf16_t* Mg = (bf16_t*)(ws + WS_MERGED);
#pragma unroll
    for (int ai = 0; ai < 2; ++ai) {
      u32x2 gA[4][2][2], tA[4][2][2];
#pragma unroll
      for (int m = 0; m < 4; ++m)
#pragma unroll
        for (int bj = 0; bj < 2; ++bj)
#pragma unroll
          for (int n = 0; n < 2; ++n) {
            const size_t idx = (size_t)(row0 + ai * 128 + m * 16) * 1024 + pn * 256 + bj * 128 + wc * 32 + n * 16 + fq * 4;
            gA[m][bj][n] = *(const u32x2*)(G + idx);
            if constexpr (MODE == M_OUT2) tA[m][bj][n] = *(const u32x2*)(Mg + idx);
          }
#pragma unroll
      for (int m = 0; m < 4; ++m)
#pragma unroll
        for (int bj = 0; bj < 2; ++bj)
#pragma unroll
          for (int n = 0; n < 2; ++n) {
            const size_t idx = (size_t)(row0 + ai * 128 + m * 16) * 1024 + pn * 256 + bj * 128 + wc * 32 + n * 16 + fq * 4;
            const u32x2 g = gA[m][bj][n];
            f32x4 v = acc[ai][bj][m][n];
            v[0] *= bflo(g.x); v[1] *= bfhi(g.x); v[2] *= bflo(g.y); v[3] *= bfhi(g.y);
            if constexpr (MODE == M_OUT2) { const u32x2 t = tA[m][bj][n]; v[0] += bflo(t.x); v[1] += bfhi(t.x); v[2] += bflo(t.y); v[3] += bfhi(t.y); }
            st4bf(Mg + idx, v);
          }
    }
  } else if constexpr (MODE == M_OUT12) {
    const bf16_t* GDp = (const bf16_t*)(ws + WS_GD); bf16_t* Mg = (bf16_t*)(ws + WS_MERGED);
#pragma unroll
    for (int ai = 0; ai < 2; ++ai) {
      u32x2 gdA[4][2][2];
#pragma unroll
      for (int m = 0; m < 4; ++m)
#pragma unroll
        for (int bj = 0; bj < 2; ++bj)
#pragma unroll
          for (int n = 0; n < 2; ++n) gdA[m][bj][n] = *(const u32x2*)(GDp + (size_t)(row0 + ai * 128 + m * 16) * 1024 + pn * 256 + bj * 128 + wc * 32 + n * 16 + fq * 4);
#pragma unroll
      for (int m = 0; m < 4; ++m)
#pragma unroll
        for (int bj = 0; bj < 2; ++bj)
#pragma unroll
          for (int n = 0; n < 2; ++n) {
            const size_t idx = (size_t)(row0 + ai * 128 + m * 16) * 1024 + pn * 256 + bj * 128 + wc * 32 + n * 16 + fq * 4;
            const u32x2 gd = gdA[m][bj][n]; f32x4 v = acc[ai][bj][m][n];
            v[0] *= fmaxf(bflo(gd.x), 1e-30f); v[1] *= fmaxf(bfhi(gd.x), 1e-30f); v[2] *= fmaxf(bflo(gd.y), 1e-30f); v[3] *= fmaxf(bfhi(gd.y), 1e-30f);
            st4bf(Mg + idx, v);
          }
    }
  } else if constexpr (MODE == M_FINALN) {
    LAS unsigned char* lds = (LAS unsigned char*)smem;
    LAS float* part = (LAS float*)lds;
    LAS float* rstdL = (LAS float*)(lds + 4096);
    float* stats = (float*)(ws + WS_ZD);
    unsigned* pctr = (unsigned*)(ws + WS_SIN);
    const int tid = otid();
#pragma unroll
    for (int ai = 0; ai < 2; ++ai)
#pragma unroll
      for (int mh = 0; mh < 2; ++mh) {
        f32x4 xA[2][2][2];
#pragma unroll
        for (int mm = 0; mm < 2; ++mm)
#pragma unroll
          for (int bj = 0; bj < 2; ++bj)
#pragma unroll
            for (int n = 0; n < 2; ++n) {
              const size_t idx = (size_t)(row0 + ai * 128 + (mh * 2 + mm) * 16) * 1024 + pn * 256 + bj * 128 + wc * 32 + n * 16 + fq * 4;
              xA[mm][bj][n] = *(const f32x4*)(P.x + idx);
            }
#pragma unroll
        for (int mm = 0; mm < 2; ++mm) {
          float sq = 0.f;
#pragma unroll
          for (int bj = 0; bj < 2; ++bj)
#pragma unroll
            for (int n = 0; n < 2; ++n) { f32x4 v = acc[ai][bj][mh * 2 + mm][n] + xA[mm][bj][n]; acc[ai][bj][mh * 2 + mm][n] = v;
              sq += v[0] * v[0] + v[1] * v[1] + v[2] * v[2] + v[3] * v[3]; }
          sq += __shfl_xor(sq, 16); sq += __shfl_xor(sq, 32);
          if (fq == 0) part[(ai * 128 + wr * 64 + (mh * 2 + mm) * 16 + fr) * 4 + wc] = sq;
        }
      }
    __syncthreads();
    if (tid < 256) __hip_atomic_store((unsigned*)stats + ((size_t)pm * 4 + pn) * 256 + tid,
                                      __float_as_uint((part[tid * 4 + 0] + part[tid * 4 + 1]) + (part[tid * 4 + 2] + part[tid * 4 + 3])), __ATOMIC_RELAXED, __HIP_MEMORY_SCOPE_AGENT);
    asm volatile("s_waitcnt vmcnt(0)" ::: "memory");
    __syncthreads();
    if (tid == 0) {
      (void)__hip_atomic_fetch_add(pctr + pm, 1u, __ATOMIC_RELAXED, __HIP_MEMORY_SCOPE_AGENT);
      while (__hip_atomic_load(pctr + pm, __ATOMIC_RELAXED, __HIP_MEMORY_SCOPE_AGENT) < 4u) __builtin_amdgcn_s_sleep(1);
    }
    __syncthreads();
    if (tid < 256) {
      unsigned* sp = (unsigned*)stats + (size_t)pm * 4 * 256 + tid;
      const float t0 = __uint_as_float(__hip_atomic_load(sp, __ATOMIC_RELAXED, __HIP_MEMORY_SCOPE_AGENT)), t1 = __uint_as_float(__hip_atomic_load(sp + 256, __ATOMIC_RELAXED, __HIP_MEMORY_SCOPE_AGENT));
      const float t2 = __uint_as_float(__hip_atomic_load(sp + 512, __ATOMIC_RELAXED, __HIP_MEMORY_SCOPE_AGENT)), t3 = __uint_as_float(__hip_atomic_load(sp + 768, __ATOMIC_RELAXED, __HIP_MEMORY_SCOPE_AGENT));
      rstdL[tid] = rsqrtf(((t0 + t1) + (t2 + t3)) * (1.f / DM) + RMS_EPS);
    }
    __syncthreads();
#pragma unroll
    for (int bj = 0; bj < 2; ++bj)
#pragma unroll
      for (int n = 0; n < 2; ++n) {
        const int col = pn * 256 + bj * 128 + wc * 32 + n * 16 + fq * 4;
        const f32x4 g4 = *(const f32x4*)(P.final_g + col);
#pragma unroll
        for (int ai = 0; ai < 2; ++ai)
#pragma unroll
          for (int m = 0; m < 4; ++m) {
            const int lr = ai * 128 + wr * 64 + m * 16 + fr;
            *(f32x4*)(P.out + (size_t)(pm * 256 + lr) * 1024 + col) = acc[ai][bj][m][n] * rstdL[lr] * g4;
          }
      }
  } else {
#pragma unroll
    for (int ai = 0; ai < 2; ++ai)
#pragma unroll
      for (int mh = 0; mh < 2; ++mh) {
        f32x4 xA[2][2][2];
#pragma unroll
        for (int mm = 0; mm < 2; ++mm)
#pragma unroll
          for (int bj = 0; bj < 2; ++bj)
#pragma unroll
            for (int n = 0; n < 2; ++n) {
              const size_t idx = (size_t)(row0 + ai * 128 + (mh * 2 + mm) * 16) * 1024 + pn * 256 + bj * 128 + wc * 32 + n * 16 + fq * 4;
              xA[mm][bj][n] = *(const f32x4*)(P.x + idx);
            }
#pragma unroll
        for (int mm = 0; mm < 2; ++mm)
#pragma unroll
          for (int bj = 0; bj < 2; ++bj)
#pragma unroll
            for (int n = 0; n < 2; ++n) {
              const size_t idx = (size_t)(row0 + ai * 128 + (mh * 2 + mm) * 16) * 1024 + pn * 256 + bj * 128 + wc * 32 + n * 16 + fq * 4;
              *(f32x4*)((float*)(ws + WS_PRE) + idx) = acc[ai][bj][mh * 2 + mm][n] + xA[mm][bj][n];
            }
      }
  }
}

template <int MODE>
__device__ __forceinline__ void gemm_tile(const Params& P, const bf16_t* __restrict__ A, const bf16_t* __restrict__ Bt, const int K, const int pm, const int pnb, const int pn_epi) {
  LAS unsigned char* lds = (LAS unsigned char*)smem;
  const int tid = otid(), wid = __builtin_amdgcn_readfirstlane(tid >> 6), lane = tid & 63, wr = wid >> 2, wc = wid & 3, fr = lane & 15, fq = lane >> 4;
  const int brow = pm * 256, bcol = pnb * 256;
  __syncthreads();
  if constexpr (MODE == M_UQ || MODE == M_UKV) {
    constexpr int NC = (MODE == M_UQ) ? 256 : 128;
    const int r = tid >> 1, hf = tid & 1;
    const bf16_t* ap = A + (size_t)(brow + r) * K + hf * (NC / 2);
    float ss = 0.f;
#pragma unroll
    for (int i = 0; i < NC / 16; ++i) {
      const u32x4 w = *(const u32x4*)(ap + i * 8);
#pragma unroll
      for (int e = 0; e < 4; ++e) { const float a = bflo(w[e]), b = bfhi(w[e]); ss += a * a + b * b; }
    }
    ss += __shfl_xor(ss, 1);
    if (hf == 0) ((LAS float*)(lds + LDS_MISC))[r] = rsqrtf(ss * (1.f / NC) + RMS_EPS);
  }
  unsigned goff[2];
  { int R, C; stage_rc(tid * 16, R, C); goff[0] = (unsigned)(R * K + C) * 2u; goff[1] = goff[0] + (unsigned)(64 * K) * 2u; }
#define SAO(b, h) (((b) * 2 + (h)) * HTB)
#define SBO(b, h) ((4 + (b) * 2 + (h)) * HTB)
#define STAGE(PO, BASE, br, kt) do { const char* _g = (const char*)((BASE) + (size_t)(br) * K + (size_t)(kt) * BK); \
    _Pragma("unroll") for (int _i = 0; _i < 2; ++_i) \
      __builtin_amdgcn_global_load_lds((const unsigned*)(_g + goff[_i]), (LAS unsigned*)(lds + (PO) + wid * 1024 + _i * 8192), 16, 0, 0); } while (0)
#define LDA(dst, b, h) _Pragma("unroll") for (int m = 0; m < 4; ++m) _Pragma("unroll") for (int k = 0; k < 2; ++k) \
    dst[m][k] = *(const LAS bf16x8*)(lds + SAO(b, h) + lds_byte(wr * 64 + m * 16 + fr, k * 32 + fq * 8))
#define LDB(dst, b, h) _Pragma("unroll") for (int n = 0; n < 2; ++n) _Pragma("unroll") for (int k = 0; k < 2; ++k) \
    dst[n][k] = *(const LAS bf16x8*)(lds + SBO(b, h) + lds_byte(wc * 32 + n * 16 + fr, k * 32 + fq * 8))
#define MMA(ai, bj, AT, BT) do { __builtin_amdgcn_s_setprio(1); \
    _Pragma("unroll") for (int m = 0; m < 4; ++m) _Pragma("unroll") for (int n = 0; n < 2; ++n) _Pragma("unroll") for (int k = 0; k < 2; ++k) \
      acc[ai][bj][m][n] = __builtin_amdgcn_mfma_f32_16x16x32_bf16(BT[n][k], AT[m][k], acc[ai][bj][m][n], 0, 0, 0); \
    __builtin_amdgcn_s_setprio(0); } while (0)
#define WAIT_V(n) asm volatile("s_waitcnt vmcnt(" #n ")" ::: "memory")
#define WAIT_L(n) asm volatile("s_waitcnt lgkmcnt(" #n ")" ::: "memory")
#define BAR __builtin_amdgcn_s_barrier()
#define SCHED __builtin_amdgcn_sched_barrier(0)
  f32x4 acc[2][2][4][2] = {};
  bf16x8 At[4][2], B0[2][2], B1[2][2];
  const int nt = K / BK;
  constexpr int NPASS = (MODE == M_OUT12) ? 2 : 1;
#pragma unroll 1
  for (int pass = 0; pass < NPASS; ++pass) {
  const bf16_t* Ap = A; const bf16_t* Bp = Bt;
  if constexpr (MODE == M_OUT12) { if (pass == 1) {
    Ap = (const bf16_t*)(P.ws + WS_A2); Bp = (const bf16_t*)(P.ws + WS_WOD);
    int l2 = lane; asm volatile("" : "+v"(l2)); const int fr2 = l2 & 15, fq2 = l2 >> 4;
    const bf16_t* GMp = (const bf16_t*)(P.ws + WS_GM); const bf16_t* GDp = (const bf16_t*)(P.ws + WS_GD);
#pragma unroll
    for (int ai = 0; ai < 2; ++ai) {
      u32x2 gmA[4][2][2], gdA[4][2][2];
#pragma unroll
      for (int m = 0; m < 4; ++m)
#pragma unroll
        for (int bj = 0; bj < 2; ++bj)
#pragma unroll
          for (int n = 0; n < 2; ++n) {
            const size_t idx = (size_t)(pm * 256 + wr * 64 + fr2 + ai * 128 + m * 16) * 1024 + pn_epi * 256 + bj * 128 + wc * 32 + n * 16 + fq2 * 4;
            gmA[m][bj][n] = *(const u32x2*)(GMp + idx); gdA[m][bj][n] = *(const u32x2*)(GDp + idx);
          }
#pragma unroll
      for (int m = 0; m < 4; ++m)
#pragma unroll
        for (int bj = 0; bj < 2; ++bj)
#pragma unroll
          for (int n = 0; n < 2; ++n) {
            const u32x2 gm = gmA[m][bj][n], gd = gdA[m][bj][n];
            acc[ai][bj][m][n][0] *= bflo(gm.x) * __builtin_amdgcn_rcpf(fmaxf(bflo(gd.x), 1e-30f));
            acc[ai][bj][m][n][1] *= bfhi(gm.x) * __builtin_amdgcn_rcpf(fmaxf(bfhi(gd.x), 1e-30f));
            acc[ai][bj][m][n][2] *= bflo(gm.y) * __builtin_amdgcn_rcpf(fmaxf(bflo(gd.y), 1e-30f));
            acc[ai][bj][m][n][3] *= bfhi(gm.y) * __builtin_amdgcn_rcpf(fmaxf(bfhi(gd.y), 1e-30f));
          }
    }
    __syncthreads();
  } }
  STAGE(SBO(0, 0), Bp, bcol, 0); STAGE(SAO(0, 0), Ap, brow, 0);
  STAGE(SBO(0, 1), Bp, bcol + 128, 0); STAGE(SAO(0, 1), Ap, brow + 128, 0);
  if (wr == 1) BAR;
  WAIT_V(4); BAR;
  STAGE(SBO(1, 0), Bp, bcol, 1); STAGE(SAO(1, 0), Ap, brow, 1); STAGE(SBO(1, 1), Bp, bcol + 128, 1);
  WAIT_V(6); BAR;
  for (int t = 0; t < nt - 2; t += 2) {
    LDB(B0, 0, 0); SCHED; LDA(At, 0, 0); STAGE(SAO(1, 1), Ap, brow + 128, t + 1);
    WAIT_L(8); BAR; WAIT_L(0); MMA(0, 0, At, B0); BAR; SCHED;
    LDB(B1, 0, 1); STAGE(SBO(0, 0), Bp, bcol, t + 2);
    BAR; WAIT_L(0); MMA(0, 1, At, B1); BAR;
    LDA(At, 0, 1); STAGE(SAO(0, 0), Ap, brow, t + 2);
    BAR; WAIT_L(0); MMA(1, 0, At, B0); BAR; SCHED;
    STAGE(SBO(0, 1), Bp, bcol + 128, t + 2);
    WAIT_V(6); BAR; MMA(1, 1, At, B1); BAR;
    LDB(B0, 1, 0); SCHED; LDA(At, 1, 0); STAGE(SAO(0, 1), Ap, brow + 128, t + 2);
    WAIT_L(8); BAR; WAIT_L(0); MMA(0, 0, At, B0); BAR; SCHED;
    LDB(B1, 1, 1); STAGE(SBO(1, 0), Bp, bcol, t + 3);
    BAR; WAIT_L(0); MMA(0, 1, At, B1); BAR;
    LDA(At, 1, 1); STAGE(SAO(1, 0), Ap, brow, t + 3);
    BAR; WAIT_L(0); MMA(1, 0, At, B0); BAR; SCHED;
    STAGE(SBO(1, 1), Bp, bcol + 128, t + 3);
    WAIT_V(6); BAR; MMA(1, 1, At, B1); BAR;
  }
  { LDB(B0, 0, 0); LDA(At, 0, 0); STAGE(SAO(1, 1), Ap, brow + 128, nt - 1);
    BAR; WAIT_L(0); MMA(0, 0, At, B0); BAR;
    LDB(B1, 0, 1); BAR; WAIT_L(0); MMA(0, 1, At, B1); BAR;
    LDA(At, 0, 1); WAIT_V(4); BAR; WAIT_L(0); MMA(1, 0, At, B0); MMA(1, 1, At, B1); BAR; }
  { LDB(B0, 1, 0); LDA(At, 1, 0); WAIT_V(2); BAR; WAIT_L(0); MMA(0, 0, At, B0); BAR;
    LDB(B1, 1, 1); WAIT_V(0); BAR; WAIT_L(0); MMA(0, 1, At, B1); BAR;
    LDA(At, 1, 1); BAR; WAIT_L(0); MMA(1, 0, At, B0); MMA(1, 1, At, B1); BAR; }
  if (wr == 0) BAR;
  }
  { int l2 = lane; asm volatile("" : "+v"(l2));
    gemm_epilogue<MODE>(P, acc, pm, pn_epi, wr, wc, l2 & 15, l2 >> 4); }
#undef SAO
#undef SBO
#undef STAGE
#undef LDA
#undef LDB
#undef MMA
}


template <int MODE>
__device__ __forceinline__ void gemm_stream(const Params& P, const bf16_t* __restrict__ A, const bf16_t* __restrict__ Bt, const int K, const int pn_lo, const int npn, const int pnb_lo) {
  LAS unsigned char* lds = (LAS unsigned char*)smem;
  const int G = GRIDX, u0 = vcu_id_(GRIDX), nunits = (NTOK / 256) * npn;
  if (u0 >= nunits) return;
  const int nmine = (nunits - u0 + G - 1) / G;
  const int tid = otid(), wid = __builtin_amdgcn_readfirstlane(tid >> 6), lane = tid & 63, wr = wid >> 2, wc = wid & 3, fr = lane & 15, fq = lane >> 4;
  const int nt = K / BK;
  unsigned goff[2];
  { int R, C; stage_rc(tid * 16, R, C); goff[0] = (unsigned)(R * K + C) * 2u; goff[1] = goff[0] + (unsigned)(64 * K) * 2u; }
  const size_t half = (size_t)128 * K;
#define SAO(b, h) (((b) * 2 + (h)) * HTB)
#define SBO(b, h) ((4 + (b) * 2 + (h)) * HTB)
#define STAGE(PO, BASE, kt) do { const char* _g = (const char*)((BASE) + (size_t)(kt) * BK); \
    _Pragma("unroll") for (int _i = 0; _i < 2; ++_i) \
      __builtin_amdgcn_global_load_lds((const unsigned*)(_g + goff[_i]), (LAS unsigned*)(lds + (PO) + wid * 1024 + _i * 8192), 16, 0, 0); } while (0)
#define LDA(dst, b, h) _Pragma("unroll") for (int m = 0; m < 4; ++m) _Pragma("unroll") for (int k = 0; k < 2; ++k) \
    dst[m][k] = *(const LAS bf16x8*)(lds + SAO(b, h) + lds_byte(wr * 64 + m * 16 + fr, k * 32 + fq * 8))
#define LDB(dst, b, h) _Pragma("unroll") for (int n = 0; n < 2; ++n) _Pragma("unroll") for (int k = 0; k < 2; ++k) \
    dst[n][k] = *(const LAS bf16x8*)(lds + SBO(b, h) + lds_byte(wc * 32 + n * 16 + fr, k * 32 + fq * 8))
#define MMA(ai, bj, AT, BT) do { __builtin_amdgcn_s_setprio(1); \
    _Pragma("unroll") for (int m = 0; m < 4; ++m) _Pragma("unroll") for (int n = 0; n < 2; ++n) _Pragma("unroll") for (int k = 0; k < 2; ++k) \
      acc[ai][bj][m][n] = __builtin_amdgcn_mfma_f32_16x16x32_bf16(BT[n][k], AT[m][k], acc[ai][bj][m][n], 0, 0, 0); \
    __builtin_amdgcn_s_setprio(0); } while (0)
  f32x4 acc[2][2][4][2] = {};
  bf16x8 At[4][2], B0[2][2], B1[2][2];
  int uiN = 0, ktN = 0, pmP, plP, ktP;
  const bf16_t *aP, *bP, *aN, *bN;
  { const int u = u0, pm = u / npn, pl = u - pm * npn; pmP = pm; plP = pl; ktP = 0;
    aP = A + (size_t)pm * 256 * K; bP = Bt + (size_t)(pnb_lo + pl) * 256 * K; aN = aP; bN = bP; }
  int pmN = pmP, plN = plP;
#define ADVANCE_N() do { ktN += 2; if (ktN == nt) { if (uiN + 1 < nmine) { ++uiN; ktN = 0; const int u = u0 + uiN * G; pmN = u / npn; plN = u - pmN * npn; \
      aN = A + (size_t)pmN * 256 * K; bN = Bt + (size_t)(pnb_lo + plN) * 256 * K; } else { ktN = nt - 2; } } } while (0)
  __syncthreads();
  STAGE(SBO(0, 0), bP, 0); STAGE(SAO(0, 0), aP, 0);
  STAGE(SBO(0, 1), bP + half, 0); STAGE(SAO(0, 1), aP + half, 0);
  if (wr == 1) BAR;
  WAIT_V(4); BAR;
  STAGE(SBO(1, 0), bP, 1); STAGE(SAO(1, 0), aP, 1); STAGE(SBO(1, 1), bP + half, 1);
  WAIT_V(6); BAR;
  ADVANCE_N();
  const int npairs = nmine * (nt >> 1);
  for (int q = 0; q < npairs; ++q) {
    LDB(B0, 0, 0); SCHED; LDA(At, 0, 0); STAGE(SAO(1, 1), aP + half, ktP + 1);
    WAIT_L(8); BAR; WAIT_L(0); MMA(0, 0, At, B0); BAR; SCHED;
    LDB(B1, 0, 1); STAGE(SBO(0, 0), bN, ktN);
    BAR; WAIT_L(0); MMA(0, 1, At, B1); BAR;
    LDA(At, 0, 1); STAGE(SAO(0, 0), aN, ktN);
    BAR; WAIT_L(0); MMA(1, 0, At, B0); BAR; SCHED;
    STAGE(SBO(0, 1), bN + half, ktN);
    WAIT_V(6); BAR; MMA(1, 1, At, B1); BAR;
    LDB(B0, 1, 0); SCHED; LDA(At, 1, 0); STAGE(SAO(0, 1), aN + half, ktN);
    WAIT_L(8); BAR; WAIT_L(0); MMA(0, 0, At, B0); BAR; SCHED;
    LDB(B1, 1, 1); STAGE(SBO(1, 0), bN, ktN + 1);
    BAR; WAIT_L(0); MMA(0, 1, At, B1); BAR;
    LDA(At, 1, 1); STAGE(SAO(1, 0), aN, ktN + 1);
    BAR; WAIT_L(0); MMA(1, 0, At, B0); BAR; SCHED;
    STAGE(SBO(1, 1), bN + half, ktN + 1);
    WAIT_V(6); BAR; MMA(1, 1, At, B1); BAR;
    if (ktP + 2 == nt) {
      { int l2 = lane; asm volatile("" : "+v"(l2));
        gemm_epilogue<MODE>(P, acc, pmP, pn_lo + plP, wr, wc, l2 & 15, l2 >> 4); }
#pragma unroll
      for (int ai = 0; ai < 2; ++ai)
#pragma unroll
        for (int bj = 0; bj < 2; ++bj)
#pragma unroll
          for (int m = 0; m < 4; ++m)
#pragma unroll
            for (int n = 0; n < 2; ++n) acc[ai][bj][m][n] = (f32x4){0.f, 0.f, 0.f, 0.f};
    }
    aP = aN; bP = bN; ktP = ktN; pmP = pmN; plP = plN;
    ADVANCE_N();
  }
  WAIT_V(0);
  if (wr == 0) BAR;
  __syncthreads();
#undef SAO
#undef SBO
#undef STAGE
#undef LDA
#undef LDB
#undef MMA
#undef ADVANCE_N
}

#define KSWZ(row, colB) ((row) * 256 + ((colB) ^ (((row) & 7) << 4)))
#define SBAR() __builtin_amdgcn_sched_barrier(0)
constexpr int AT_NBUF = 3, AT_V = 64 * 64 * 2, AT_K = 64 * 256, AT_KOFF = AT_NBUF * AT_V, AT_WSOFF = AT_NBUF * (AT_V + AT_K);
__device__ __forceinline__ int crow(int r, int hi) { return (r & 3) + 8 * (r >> 2) + 4 * hi; }
__device__ __forceinline__ int v_st(int k, int c) { const int kk = (k & ~0xC) | ((k & 4) << 1) | ((k & 8) >> 1); return ((kk >> 3) * 2 + (c >> 5)) * 512 + ((kk & 7) * 32 + (c & 31)) * 2; }
__device__ __forceinline__ int v_rd_base(int lane) { return ((lane & 3) << 3) | (((lane >> 2) & 3) << 6) | (((lane >> 4) & 1) << 5) | (((lane >> 5) & 1) << 8); }
constexpr int v_rd_off(int d0, int ks, int half) { return d0 * 512 + ks * 2048 + half * 1024; }
template <int OFF> __device__ __forceinline__ s16x4 tr_read(int vb) {
  s16x4 r; asm volatile("ds_read_b64_tr_b16 %0, %1 offset:%2" : "=&v"(r) : "v"(vb), "i"(OFF) : "memory"); return r;
}
template <int D0> __device__ __forceinline__ void pv_one(f32x16& od, int vb, bf16x8 pa0, bf16x8 pa1, bf16x8 pa2, bf16x8 pa3) {
  const s16x4 l0 = tr_read<v_rd_off(D0, 0, 0)>(vb), h0 = tr_read<v_rd_off(D0, 0, 1)>(vb), l1 = tr_read<v_rd_off(D0, 1, 0)>(vb), h1 = tr_read<v_rd_off(D0, 1, 1)>(vb);
  const s16x4 l2 = tr_read<v_rd_off(D0, 2, 0)>(vb), h2 = tr_read<v_rd_off(D0, 2, 1)>(vb), l3 = tr_read<v_rd_off(D0, 3, 0)>(vb), h3 = tr_read<v_rd_off(D0, 3, 1)>(vb);
  asm volatile("s_waitcnt lgkmcnt(0)" ::: "memory"); SBAR();
#define PK(L, H) (bf16x8){L[0], L[1], L[2], L[3], H[0], H[1], H[2], H[3]}
  od = __builtin_amdgcn_mfma_f32_32x32x16_bf16(pa0, PK(l0, h0), od, 0, 0, 0);
  od = __builtin_amdgcn_mfma_f32_32x32x16_bf16(pa1, PK(l1, h1), od, 0, 0, 0);
  od = __builtin_amdgcn_mfma_f32_32x32x16_bf16(pa2, PK(l2, h2), od, 0, 0, 0);
  od = __builtin_amdgcn_mfma_f32_32x32x16_bf16(pa3, PK(l3, h3), od, 0, 0, 0);
#undef PK
}
__device__ __forceinline__ void partialSM(f32x16& p0, f32x16& p1, float& m_reg, float& mn, float& alpha, const float C, const float thr_raw) {
  float pmax = p0[0];
#pragma unroll
  for (int r = 1; r < 16; ++r) pmax = fmaxf(pmax, p0[r]);
#pragma unroll
  for (int r = 0; r < 16; ++r) pmax = fmaxf(pmax, p1[r]);
  { auto rr = __builtin_amdgcn_permlane32_swap(__float_as_uint(pmax), __float_as_uint(pmax), false, false);
    pmax = fmaxf(__uint_as_float(rr[0]), __uint_as_float(rr[1])); }
  if (__builtin_expect(__all(pmax - m_reg <= thr_raw), 1)) { mn = m_reg; alpha = 1.f; }
  else { mn = fmaxf(m_reg, pmax); alpha = __builtin_amdgcn_exp2f((m_reg - mn) * C); m_reg = mn; }
  const float mnC = -mn * C;
#pragma unroll
  for (int r = 0; r < 16; ++r) p0[r] = fmaf(p0[r], C, mnC);
#pragma unroll
  for (int r = 0; r < 16; ++r) p1[r] = fmaf(p1[r], C, mnC);
#pragma unroll
  for (int r = 0; r < 16; ++r) p0[r] = __builtin_amdgcn_exp2f(p0[r]);
}
__device__ __forceinline__ void finishSM(f32x16& p0, f32x16& p1, float alpha, float& l_reg, bf16x8& pa0, bf16x8& pa1, bf16x8& pa2, bf16x8& pa3) {
#pragma unroll
  for (int r = 0; r < 16; ++r) p1[r] = __builtin_amdgcn_exp2f(p1[r]);
  float ps = 0;
#pragma unroll
  for (int r = 0; r < 16; ++r) ps += p0[r];
#pragma unroll
  for (int r = 0; r < 16; ++r) ps += p1[r];
  { auto rr = __builtin_amdgcn_permlane32_swap(__float_as_uint(ps), __float_as_uint(ps), false, false);
    ps = __uint_as_float(rr[0]) + __uint_as_float(rr[1]); }
  l_reg = l_reg * alpha + ps;
#define PK4(Pv, BASE, OUT) do { unsigned a0 = cvtpk(Pv[BASE + 0], Pv[BASE + 1]), a1 = cvtpk(Pv[BASE + 2], Pv[BASE + 3]);   \
    unsigned b0 = cvtpk(Pv[BASE + 4], Pv[BASE + 5]), b1 = cvtpk(Pv[BASE + 6], Pv[BASE + 7]);                              \
    auto r0 = __builtin_amdgcn_permlane32_swap(a0, b0, false, false); auto r1 = __builtin_amdgcn_permlane32_swap(a1, b1, false, false); \
    u32x4 w = {r0[0], r1[0], r0[1], r1[1]}; OUT = *reinterpret_cast<bf16x8*>(&w); } while (0)
  PK4(p0, 0, pa0); PK4(p0, 8, pa1); PK4(p1, 0, pa2); PK4(p1, 8, pa3);
#undef PK4
}

template <int NQ, bool MASK>
__device__ __forceinline__ void attn_body(const bf16_t* __restrict__ Qb, const long ldq, const bf16_t* __restrict__ Kh, const long ldk,
                                          const bf16_t* __restrict__ Vh, const long ldv, const int NT, const float C, const float thr_raw, const int mdelta,
                                          f32x16 (&o)[2], float& m_reg, float& l_reg) {
  LAS unsigned char* lds = (LAS unsigned char*)smem;
  const int tid = otid(), wid = __builtin_amdgcn_readfirstlane(tid >> 6), lane = tid & 63, r32 = lane & 31, hi = lane >> 5;
  LAS float* wsl = (LAS float*)(lds + AT_WSOFF) + wid * 64; LAS float* al_l = wsl + 32;
  m_reg = MASK ? -30000.f : -1e30f; l_reg = 0.f;
  o[0] = f32x16{}; o[1] = f32x16{};
  bf16x8 qr[NQ];
  const bf16_t* Qw = Qb + (long)(wid * 32 + r32) * ldq + hi * 8;
#pragma unroll
  for (int d0 = 0; d0 < NQ; ++d0) qr[d0] = *(const bf16x8*)(Qw + d0 * 16);
  int kr0, kc0, kr1 = 0, kc1 = 0;
  if constexpr (NQ == 6) { kr0 = tid / 12; kc0 = (tid % 12) * 8; const int c1 = 512 + (tid & 255); kr1 = c1 / 12; kc1 = (c1 % 12) * 8; }
  else { kr0 = tid >> 3; kc0 = (tid & 7) * 8; }
  const int vr = tid >> 3, vc = (tid & 7) * 8;
  const int kst0 = KSWZ(kr0, kc0 * 2), kst1 = KSWZ(kr1, kc1 * 2), vst = v_st(vr, vc);
  const int vb0 = (int)(unsigned)(uintptr_t)lds + v_rd_base(lane);
  struct { bf16x8 v, k0, k1; } sr_[2];
#define SLOAD(i, kk0) do { sr_[i].v = *(const bf16x8*)(Vh + (long)((kk0) + vr) * ldv + vc); sr_[i].k0 = *(const bf16x8*)(Kh + (long)((kk0) + kr0) * ldk + kc0); \
    if constexpr (NQ == 6) sr_[i].k1 = *(const bf16x8*)(Kh + (long)((kk0) + kr1) * ldk + kc1); } while (0)
#define SWRITE(b, i) do { *(LAS bf16x8*)(lds + (b) * AT_V + vst) = sr_[i].v; *(LAS bf16x8*)(lds + AT_KOFF + (b) * AT_K + kst0) = sr_[i].k0; \
    if constexpr (NQ == 6) *(LAS bf16x8*)(lds + AT_KOFF + (b) * AT_K + kst1) = sr_[i].k1; } while (0)
#define SWAIT() do { if constexpr (NQ == 6) asm volatile("s_waitcnt vmcnt(3)" ::: "memory"); else asm volatile("s_waitcnt vmcnt(2)" ::: "memory"); } while (0)
#define RESC(a) do { if (__any((a) < 1.f)) { if (hi == 0) al_l[r32] = (a); asm volatile("s_waitcnt lgkmcnt(0)" ::: "memory"); \
    _Pragma("unroll") for (int d = 0; d < 2; ++d) _Pragma("unroll") for (int r = 0; r < 16; ++r) o[d][r] *= al_l[crow(r, hi)]; } } while (0)
#define QKT(P0, P1, b, tile) do { P0 = f32x16{}; P1 = f32x16{}; \
    _Pragma("unroll") for (int d0 = 0; d0 < NQ; ++d0) { const int cb = (d0 * 16 + hi * 8) * 2; \
      const bf16x8 b0 = *(const LAS bf16x8*)(lds + AT_KOFF + (b) * AT_K + KSWZ(r32, cb)); \
      const bf16x8 b1 = *(const LAS bf16x8*)(lds + AT_KOFF + (b) * AT_K + KSWZ(32 + r32, cb)); \
      P0 = __builtin_amdgcn_mfma_f32_32x32x16_bf16(b0, qr[d0], P0, 0, 0, 0); \
      P1 = __builtin_amdgcn_mfma_f32_32x32x16_bf16(b1, qr[d0], P1, 0, 0, 0); } \
    if constexpr (MASK) { const int dl = mdelta + (tile) * 64 - (wid * 32 + r32) + 4 * hi; \
      _Pragma("unroll") for (int r = 0; r < 16; ++r) { const int dd = dl + (r & 3) + 8 * (r >> 2); \
        if ((unsigned)(dd + 64) > 128u) P0[r] = -1e30f; if ((unsigned)(dd + 96) > 128u) P1[r] = -1e30f; } } } while (0)
#define PV(b) do { pv_one<0>(o[0], vb0 + (b) * AT_V, pa0, pa1, pa2, pa3); pv_one<1>(o[1], vb0 + (b) * AT_V, pa0, pa1, pa2, pa3); } while (0)
  f32x16 pA0, pA1, pB0, pB1; float mnA = 0.f, mnB = 0.f, alA = 1.f, alB = 1.f; bf16x8 pa0, pa1, pa2, pa3;
  int jlo = 0, jhi = NT - 1;
  if constexpr (MASK) {
    const int a = 32 * wid - 127 - mdelta + 63, b = 32 * wid + 95 - mdelta;
    jlo = a >= 0 ? a / 64 : -((-a + 63) / 64); jhi = b >= 0 ? b / 64 : -((-b + 63) / 64);
    jlo = jlo < 0 ? 0 : jlo; jhi = jhi > NT - 1 ? NT - 1 : jhi;
  }
#define NEED(j) (!MASK || ((j) >= jlo && (j) <= jhi))
  SLOAD(0, 0); asm volatile("s_waitcnt vmcnt(0)" ::: "memory"); SWRITE(0, 0); __syncthreads();
  if (NEED(0)) { QKT(pA0, pA1, 0, 0); partialSM(pA0, pA1, m_reg, mnA, alA, C, thr_raw); }
  SLOAD(1, 64); if (2 < NT) SLOAD(0, 128);
  SWAIT(); SWRITE(1, 1); __syncthreads();
#define STEP(PC0, PC1, ALC, MNC, PP0, PP1, ALP, BC, BP, BN, T) do { \
    SBAR(); QKT(PC0, PC1, BC, T); \
    finishSM(PP0, PP1, ALP, l_reg, pa0, pa1, pa2, pa3); __builtin_amdgcn_iglp_opt(2); SBAR();     \
    if ((T) + 2 < NT) { if ((T) & 1) SLOAD(1, ((T) + 2) * 64); else SLOAD(0, ((T) + 2) * 64); } SBAR(); \
    PV(BP); partialSM(PC0, PC1, m_reg, MNC, ALC, C, thr_raw); __builtin_amdgcn_iglp_opt(2); \
    SWAIT(); if ((T) & 1) SWRITE(BN, 0); else SWRITE(BN, 1); \
    RESC(ALC); __syncthreads(); } while (0)
  for (int j = 1; j + 1 < NT; j += 6) {
    STEP(pB0, pB1, alB, mnB, pA0, pA1, alA, 1, 0, 2, j);
    STEP(pA0, pA1, alA, mnA, pB0, pB1, alB, 2, 1, 0, j + 1);
    STEP(pB0, pB1, alB, mnB, pA0, pA1, alA, 0, 2, 1, j + 2);
    STEP(pA0, pA1, alA, mnA, pB0, pB1, alB, 1, 0, 2, j + 3);
    STEP(pB0, pB1, alB, mnB, pA0, pA1, alA, 2, 1, 0, j + 4);
    STEP(pA0, pA1, alA, mnA, pB0, pB1, alB, 0, 2, 1, j + 5);
  }
  SBAR(); QKT(pB0, pB1, 1, NT - 1);
  finishSM(pA0, pA1, alA, l_reg, pa0, pa1, pa2, pa3); SBAR();
  PV(0); partialSM(pB0, pB1, m_reg, mnB, alB, C, thr_raw);
  RESC(alB);
  finishSM(pB0, pB1, alB, l_reg, pa0, pa1, pa2, pa3); SBAR();
  PV(1);
#undef STEP
#undef NEED
  if (hi == 0) wsl[r32] = l_reg;
  asm volatile("s_waitcnt lgkmcnt(0)" ::: "memory");
#pragma unroll
  for (int r = 0; r < 16; ++r) { const float rl = __builtin_amdgcn_rcpf(wsl[crow(r, hi)]); o[0][r] *= rl; o[1][r] *= rl; }
#undef SLOAD
#undef SWRITE
#undef SWAIT
#undef RESC
#undef QKT
#undef PV
}

constexpr int DL_V = 0, DL_K = 6 * 8192, DL_WS = 12 * 8192, DL_OUT = 12 * 8192 + 2048;
#define KSW2(row, colB) ((row) * 128 + ((colB) ^ ((((row) >> 1) & 7) << 4)))
__device__ __forceinline__ void dil_compute(const bf16x8 (&qr)[4], const int mdelta, f32x16 (&o)[2], float& m_reg, float& l_reg) {
  LAS unsigned char* lds = (LAS unsigned char*)smem;
  const int tid = otid(), wid = __builtin_amdgcn_readfirstlane(tid >> 6), lane = tid & 63, r32 = lane & 31, hi = lane >> 5;
  LAS float* wsl = (LAS float*)(lds + DL_WS) + wid * 64; LAS float* al_l = wsl + 32;
  m_reg = -30000.f; l_reg = 0.f; o[0] = f32x16{}; o[1] = f32x16{};
  int jlo, jhi;
  { const int a = 32 * wid - 127 - mdelta + 63, b = 32 * wid + 95 - mdelta;
    jlo = a >= 0 ? a / 64 : -((-a + 63) / 64); jhi = b >= 0 ? b / 64 : -((-b + 63) / 64);
    jlo = jlo < 0 ? 0 : jlo; jhi = jhi > 5 ? 5 : jhi; }
  const int vb0 = (int)(unsigned)(uintptr_t)lds + DL_V + v_rd_base(lane);
#pragma unroll 1
  for (int j = jlo; j <= jhi; ++j) {
    f32x16 p0 = f32x16{}, p1 = f32x16{};
    LAS unsigned char* kt = lds + DL_K + j * 8192;
#pragma unroll
    for (int d0 = 0; d0 < 4; ++d0) { const int cb = (d0 * 16 + hi * 8) * 2;
      const bf16x8 b0 = *(const LAS bf16x8*)(kt + KSW2(r32, cb)), b1 = *(const LAS bf16x8*)(kt + KSW2(32 + r32, cb));
      p0 = __builtin_amdgcn_mfma_f32_32x32x16_bf16(b0, qr[d0], p0, 0, 0, 0);
      p1 = __builtin_amdgcn_mfma_f32_32x32x16_bf16(b1, qr[d0], p1, 0, 0, 0); }
    { const int dl = mdelta + j * 64 - (wid * 32 + r32) + 4 * hi;
#pragma unroll
      for (int r = 0; r < 16; ++r) { const int dd = dl + (r & 3) + 8 * (r >> 2);
        if ((unsigned)(dd + 64) > 128u) p0[r] = -1e30f; if ((unsigned)(dd + 96) > 128u) p1[r] = -1e30f; } }
    float mn, alpha; bf16x8 pa0, pa1, pa2, pa3;
    partialSM(p0, p1, m_reg, mn, alpha, LOG2E, 8.f);
    if (__any(alpha < 1.f)) { if (hi == 0) al_l[r32] = alpha; asm volatile("s_waitcnt lgkmcnt(0)" ::: "memory");
#pragma unroll
      for (int d = 0; d < 2; ++d)
#pragma unroll
        for (int r = 0; r < 16; ++r) o[d][r] *= al_l[crow(r, hi)]; }
    finishSM(p0, p1, alpha, l_reg, pa0, pa1, pa2, pa3);
    const int vb = vb0 + j * 8192;
    pv_one<0>(o[0], vb, pa0, pa1, pa2, pa3); pv_one<1>(o[1], vb, pa0, pa1, pa2, pa3);
  }
  if (hi == 0) wsl[r32] = l_reg;
  asm volatile("s_waitcnt lgkmcnt(0)" ::: "memory");
#pragma unroll
  for (int r = 0; r < 16; ++r) { const float rl = __builtin_amdgcn_rcpf(wsl[crow(r, hi)]); o[0][r] *= rl; o[1][r] *= rl; }
}

__device__ __forceinline__ int perm_in(int p) { const int g = p >> 5, n = (p >> 4) & 1, fq = (p >> 2) & 3, j = p & 3; return (g >> 1) * 64 + (g & 1) * 16 + n * 32 + fq * 4 + j; }
__device__ __forceinline__ void prep_store(bf16_t* dst, const float* W, const int ldw, const int sc, const int k0, const int kvalid, const float* g) {
  float v[8];
#pragma unroll
  for (int e = 0; e < 8; ++e) { const int k = k0 + e; float t = 0.f; if (sc >= 0 && k < kvalid) { t = W[(size_t)k * ldw + sc]; if (g) t *= g[k]; } v[e] = t; }
  u32x4 w = {cvtpk(v[0], v[1]), cvtpk(v[2], v[3]), cvtpk(v[4], v[5]), cvtpk(v[6], v[7])};
  *(u32x4*)dst = w;
}
__device__ void phase_prep(const Params& P) {
  unsigned char* ws = P.ws;
  const long gtid = (long)blockIdx.x * NTHREADS + otid(), gsz = (long)GRIDX * NTHREADS;
  for (long it = gtid; it < 8192L * 128; it += gsz) {
    const int n = (int)(it % 8192), k8 = (int)(it / 8192);
    const int t = n >> 8, l = perm_in(n & 255);
    int sc;
    if (t == 0) sc = l;
    else if (t == 1) sc = (l < 128) ? 256 + l : (l < 160 ? 384 + (l - 128) : -1);
    else if (t < 4) sc = 416 + (t - 2) * 256 + l;
    else if (t < 8) sc = 6048 + (t - 4) * 256 + l;
    else if (t < 12) sc = 7072 + (t - 8) * 256 + l;
    else if (t < 18) sc = 928 + (t - 12) * 256 + l;
    else if (t < 24) sc = 2464 + (t - 18) * 256 + l;
    else if (t < 30) sc = 4000 + (t - 24) * 256 + l;
    else sc = 5536 + (t - 30) * 256 + l;
    prep_store((bf16_t*)(ws + WS_WIN) + (size_t)n * 1024 + k8 * 8, P.w_in, INW, sc, k8 * 8, 1024, nullptr);
  }
  for (long it = gtid; it < 1024L * 32; it += gsz) {
    const int n = (int)(it % 1024), k8 = (int)(it / 1024);
    const int t = n >> 8, p = n & 255, gi = p >> 5, nn = (p >> 4) & 1, fq = (p >> 2) & 3, j = p & 3;
    const int head = 2 * t + (gi >> 2), sub = gi & 3;
    int sc;
    if (sub < 2) sc = head * 96 + sub * 32 + nn * 16 + fq * 4 + j;
    else if (sub == 2) sc = head * 96 + 64 + nn * 16 + fq * 4 + j;
    else sc = -1;
    prep_store((bf16_t*)(ws + WS_WUQ) + (size_t)n * 256 + k8 * 8, P.w_uq, 768, sc, k8 * 8, 256, P.gq);
  }
  for (long it = gtid; it < 1024L * 32; it += gsz) {
    const int n = (int)(it % 1024), k8 = (int)(it / 1024);
    prep_store((bf16_t*)(ws + WS_WUKV) + (size_t)n * 256 + k8 * 8, P.w_ukv, 1024, n, k8 * 8, 128, P.gkv);
  }
  for (long it = gtid; it < 1024L * 64; it += gsz) {
    const int n = (int)(it % 1024), k8 = (int)(it / 1024);
    prep_store((bf16_t*)(ws + WS_WOM) + (size_t)n * 512 + k8 * 8, P.w_om, 1024, n, k8 * 8, 512, nullptr);
    prep_store((bf16_t*)(ws + WS_WOD) + (size_t)n * 512 + k8 * 8, P.w_od, 1024, n, k8 * 8, 512, nullptr);
  }
  for (long it = gtid; it < 1024L * 128; it += gsz) {
    const int n = (int)(it % 1024), k8 = (int)(it / 1024);
    prep_store((bf16_t*)(ws + WS_WOUT) + (size_t)n * 1024 + k8 * 8, P.w_out, 1024, n, k8 * 8, 1024, nullptr);
  }
  for (long it = gtid; it < (long)NTOK * 32; it += gsz) {
    const int tok = (int)(it >> 5), i = (int)(it & 31);
    const double ang = (double)P.pos[tok] * (double)P.inv_freq[i];
    double rev = ang * 0.15915494309189535; rev -= floor(rev);
    const float rf = (float)rev;
    ((float*)(ws + WS_COS))[it] = __builtin_amdgcn_cosf(rf);
    ((float*)(ws + WS_SIN))[it] = __builtin_amdgcn_sinf(rf);
  }
  {
    const int lane = otid() & 63; const long wv = gtid >> 6, nwv = gsz >> 6;
    bf16_t* H = (bf16_t*)P.out;
    f32x4 g4[4];
#pragma unroll
    for (int c = 0; c < 4; ++c) g4[c] = *(const f32x4*)(P.attn_g + c * 256 + lane * 4);
    for (long row = wv; row < NTOK; row += nwv) {
      const float* xr = P.x + row * DM; f32x4 v[4]; float ss = 0.f;
#pragma unroll
      for (int c = 0; c < 4; ++c) { v[c] = *(const f32x4*)(xr + c * 256 + lane * 4); ss += v[c][0] * v[c][0] + v[c][1] * v[c][1] + v[c][2] * v[c][2] + v[c][3] * v[c][3]; }
      ss = wave_sum(ss);
      const float rs = rsqrtf(ss * (1.f / DM) + RMS_EPS);
#pragma unroll
      for (int c = 0; c < 4; ++c) { f32x4 t = v[c] * rs * g4[c]; st4bf(H + row * DM + c * 256 + lane * 4, t); }
    }
  }
}

constexpr int STAGGER_TICKS = 0;
template <int MODE>
__device__ void phase_gemm(const Params& P, const bf16_t* A, const bf16_t* Bt, const int K, const int pn_lo, const int npn, const int pnb_lo) {
  const int G = GRIDX, v = vcu_id_(GRIDX), nunits = (NTOK / 256) * npn;
  const bool xl = (G == 256) && ((npn & 3) == 0);
  if constexpr (MODE == M_IN) {
    const int ticks = (v & 7) * STAGGER_TICKS;
    if (ticks > 0) { const unsigned long long t0 = __builtin_amdgcn_s_memrealtime(); while (__builtin_amdgcn_s_memrealtime() - t0 < (unsigned long long)ticks) __builtin_amdgcn_s_sleep(8); }
  }
  const int nr = xl ? (npn >> 1) : (v < nunits ? (nunits - v + G - 1) / G : 0);
#pragma unroll 1
  for (int i = 0; i < nr; ++i) {
    int pm, pl;
    if (xl) { pm = 16 * (v >> 5) + 8 * (i & 1) + (v & 7); pl = 4 * (i >> 1) + ((v & 31) >> 3); }
    else { const int u = v + i * G; pm = u / npn; pl = u - pm * npn; }
    gemm_tile<MODE>(P, A, Bt, K, pm, pnb_lo + pl, pn_lo + pl);
  }
  __syncthreads();
}

struct DilUnit { const bf16_t* Qb; const bf16_t* Kb; const bf16_t* Vb; long ld; int mdelta, b, p0, dil, rho, gh; };
__device__ __forceinline__ DilUnit dil_decode(const Params& P, const int u) {
  const bf16_t* QD = (const bf16_t*)(P.ws + WS_QD); const bf16_t* KD = (const bf16_t*)(P.ws + WS_KD); const bf16_t* VD = (const bf16_t*)(P.ws + WS_VD);
  const int g = u >> 10, rem = u & 1023, b = rem >> 8, h8 = (rem >> 5) & 7, xx = rem & 31;
  const int dil = (g == 0) ? 1 : (g == 1 ? 4 : 16), L = SEQ / dil;
  const int rho = xx % dil, blk = xx / dil, gh = g * 8 + h8, p0 = blk * 256;
  int t0 = p0 / 64 - 1; t0 = t0 < 0 ? 0 : t0; if (t0 > L / 64 - 6) t0 = L / 64 - 6;
  const int k0 = t0 * 64;
  DilUnit U; U.ld = (long)dil * 1536; U.mdelta = k0 - p0; U.b = b; U.p0 = p0; U.dil = dil; U.rho = rho; U.gh = gh;
  U.Qb = QD + ((long)b * SEQ + (long)p0 * dil + rho) * 1536 + gh * 64;
  U.Kb = KD + ((long)b * SEQ + (long)k0 * dil + rho) * 1536 + gh * 64;
  U.Vb = VD + ((long)b * SEQ + (long)k0 * dil + rho) * 1536 + gh * 64;
  return U;
}
__device__ void phase_dilated(const Params& P) {
  unsigned char* ws = P.ws;
  LAS unsigned char* lds = (LAS unsigned char*)smem;
  bf16_t* OG = (bf16_t*)(ws + WS_OG); float* LSE = (float*)(ws + WS_LSE);
  const int tid = otid(), wid = __builtin_amdgcn_readfirstlane(tid >> 6), lane = tid & 63, r32 = lane & 31, hi = lane >> 5;
  const int sr = tid >> 3, sc = (tid & 7) * 8, kst = KSW2(sr, sc * 2), vst = v_st(sr, sc);
  const int G = GRIDX;
  int u = vcu_id_(G);
  if (u >= 3072) return;
  DilUnit U = dil_decode(P, u);
  bf16x8 kk[6], vv[6], qn[4];
#define DIL_LOADS(UU) do { _Pragma("unroll") for (int t = 0; t < 6; ++t) { kk[t] = *(const bf16x8*)((UU).Kb + (long)(t * 64 + sr) * (UU).ld + sc); vv[t] = *(const bf16x8*)((UU).Vb + (long)(t * 64 + sr) * (UU).ld + sc); } \
    _Pragma("unroll") for (int d0 = 0; d0 < 4; ++d0) qn[d0] = *(const bf16x8*)((UU).Qb + (long)(wid * 32 + r32) * (UU).ld + hi * 8 + d0 * 16); } while (0)
  DIL_LOADS(U);
#pragma unroll 1
  for (; u < 3072; u += G) {
    const DilUnit C = U;
    bf16x8 qr[4];
#pragma unroll
    for (int t = 0; t < 6; ++t) { *(LAS bf16x8*)(lds + DL_K + t * 8192 + kst) = kk[t]; *(LAS bf16x8*)(lds + DL_V + t * 8192 + vst) = vv[t]; }
#pragma unroll
    for (int d0 = 0; d0 < 4; ++d0) qr[d0] = qn[d0];
    __syncthreads();
    if (u + G < 3072) { U = dil_decode(P, u + G); DIL_LOADS(U); }
    f32x16 o[2]; float m_reg, l_reg;
    dil_compute(qr, C.mdelta, o, m_reg, l_reg);
    {
      LAS unsigned char* ob = lds + DL_OUT + wid * (32 * 128);
#pragma unroll
      for (int r = 0; r < 16; ++r)
#pragma unroll
        for (int d0 = 0; d0 < 2; ++d0) *(LAS unsigned short*)(ob + crow(r, hi) * 128 + (d0 * 32 + r32) * 2) = (unsigned short)(cvtpk(o[d0][r], 0.f) & 0xffffu);
#pragma unroll
      for (int i = 0; i < 4; ++i) { const int row = (lane >> 3) + 8 * i, ch = lane & 7;
        const u32x4 w = *(const LAS u32x4*)(ob + row * 128 + ch * 16);
        const long tok = (long)C.b * SEQ + (long)(C.p0 + wid * 32 + row) * C.dil + C.rho;
        *(u32x4*)(OG + tok * 1536 + C.gh * 64 + ch * 8) = w; }
    }
    if (hi == 0) { const long tok = (long)C.b * SEQ + (long)(C.p0 + wid * 32 + r32) * C.dil + C.rho; LSE[tok * 24 + C.gh] = m_reg + __logf(l_reg); }
    __syncthreads();
  }
#undef DIL_LOADS
}

__device__ void phase_combine(const Params& P) {
  unsigned char* ws = P.ws;
  const bf16_t* OG = (const bf16_t*)(ws + WS_OG); const float* LSE = (const float*)(ws + WS_LSE); const bf16_t* ZD = (const bf16_t*)(ws + WS_ZD);
  bf16_t* A2 = (bf16_t*)(ws + WS_A2);
  const long gtid = (long)blockIdx.x * NTHREADS + otid(), gsz = (long)GRIDX * NTHREADS;
  for (long it = gtid; it < (long)NTOK * 64; it += gsz) {
    const long tok = it >> 6; const int c8 = (int)(it & 63), hh = c8 >> 3, col = c8 * 8;
    const float l0 = LSE[tok * 24 + hh], l1 = LSE[tok * 24 + 8 + hh], l2 = LSE[tok * 24 + 16 + hh];
    const float mx = fmaxf(l0, fmaxf(l1, l2));
    float w0 = __expf(l0 - mx), w1 = __expf(l1 - mx), w2 = __expf(l2 - mx);
    const float inv = 1.f / (w0 + w1 + w2); w0 *= inv; w1 *= inv; w2 *= inv;
    const u32x4 a = *(const u32x4*)(OG + tok * 1536 + col), bq = *(const u32x4*)(OG + tok * 1536 + 512 + col), c = *(const u32x4*)(OG + tok * 1536 + 1024 + col);
    const u32x4 z = *(const u32x4*)(ZD + tok * 512 + col);
    u32x4 r;
#pragma unroll
    for (int e = 0; e < 4; ++e) {
      const float lo = (w0 * bflo(a[e]) + w1 * bflo(bq[e]) + w2 * bflo(c[e])) * bflo(z[e]);
      const float hi_ = (w0 * bfhi(a[e]) + w1 * bfhi(bq[e]) + w2 * bfhi(c[e])) * bfhi(z[e]);
      r[e] = cvtpk(lo, hi_);
    }
    *(u32x4*)(A2 + tok * 512 + col) = r;
  }
}

__device__ void phase_kpe(const Params& P) {
  unsigned char* ws = P.ws;
  const bf16_t* CKVR = (const bf16_t*)(ws + WS_CKVR); bf16_t* MK = (bf16_t*)(ws + WS_MK);
  const float* cosT = (const float*)(ws + WS_COS); const float* sinT = (const float*)(ws + WS_SIN);
  const long gtid = (long)blockIdx.x * NTHREADS + otid(), gsz = (long)GRIDX * NTHREADS;
  for (long it = gtid; it < (long)NTOK * 4; it += gsz) {
    const long tok = it >> 2; const int hq = (int)(it & 3);
    const u32x4 r0 = *(const u32x4*)(CKVR + tok * 256 + 128), r1 = *(const u32x4*)(CKVR + tok * 256 + 136),
                r2 = *(const u32x4*)(CKVR + tok * 256 + 144), r3 = *(const u32x4*)(CKVR + tok * 256 + 152);
    float a[16], bb[16];
#pragma unroll
    for (int e = 0; e < 4; ++e) { a[2 * e] = bflo(r0[e]); a[2 * e + 1] = bfhi(r0[e]); a[8 + 2 * e] = bflo(r1[e]); a[8 + 2 * e + 1] = bfhi(r1[e]);
                                  bb[2 * e] = bflo(r2[e]); bb[2 * e + 1] = bfhi(r2[e]); bb[8 + 2 * e] = bflo(r3[e]); bb[8 + 2 * e + 1] = bfhi(r3[e]); }
    float o1[16], o2[16];
#pragma unroll
    for (int q = 0; q < 8; ++q) {
      const f32x4 c4 = *(const f32x4*)(cosT + tok * 32 + 4 * q), s4 = *(const f32x4*)(sinT + tok * 32 + 4 * q);
      o1[2 * q] = a[2 * q] * c4[0] - bb[2 * q] * s4[0];             o2[2 * q] = bb[2 * q] * c4[0] + a[2 * q] * s4[0];
      o1[2 * q + 1] = a[2 * q + 1] * c4[2] - bb[2 * q + 1] * s4[2]; o2[2 * q + 1] = bb[2 * q + 1] * c4[2] + a[2 * q + 1] * s4[2];
    }
    u32x4 w0, w1, w2, w3;
#pragma unroll
    for (int e = 0; e < 4; ++e) { w0[e] = cvtpk(o1[2 * e], o1[2 * e + 1]); w1[e] = cvtpk(o1[8 + 2 * e], o1[8 + 2 * e + 1]);
                                  w2[e] = cvtpk(o2[2 * e], o2[2 * e + 1]); w3[e] = cvtpk(o2[8 + 2 * e], o2[8 + 2 * e + 1]); }
    const long b = tok / SEQ, s_ = tok % SEQ;
#pragma unroll
    for (int hh = 0; hh < 2; ++hh) { bf16_t* kr = MK + ((b * 8 + hq * 2 + hh) * SEQ + s_) * 96 + 64;
      *(u32x4*)(kr) = w0; *(u32x4*)(kr + 8) = w1; *(u32x4*)(kr + 16) = w2; *(u32x4*)(kr + 24) = w3; }
  }
}

__device__ void phase_mla(const Params& P) {
  unsigned char* ws = P.ws;
  const bf16_t* MQ = (const bf16_t*)(ws + WS_MQ); const bf16_t* MK = (const bf16_t*)(ws + WS_MK); const bf16_t* MV = (const bf16_t*)(ws + WS_MV);
  const bf16_t* ZM = (const bf16_t*)(ws + WS_ZM); bf16_t* A1 = (bf16_t*)(ws + WS_A1);
  const int tid = otid(), wid = tid >> 6, lane = tid & 63, r32 = lane & 31, hi = lane >> 5;
  const float scale = 0.10206207261596577f;
  const int G = GRIDX;
  for (int u0 = blockIdx.x; u0 < 1024; u0 += G) {
    int u = u0;
    if (G == 256) { const int i = u0 >> 8, bx = u0 & 255; u = (i * 8 + (bx & 7)) * 32 + (bx >> 3); }
    const int bh = u >> 5, qb = u & 31, b = bh >> 3, h = bh & 7;
    const bf16_t* Qb = MQ + ((long)bh * SEQ + qb * 256) * 96;
    f32x16 o[2]; float m_reg, l_reg;
    attn_body<6, false>(Qb, 96, MK + (long)bh * SEQ * 96, 96, MV + (long)bh * SEQ * 64, 64, SEQ / 64, scale * LOG2E, 8.f / scale, 0, o, m_reg, l_reg);
    {
      LAS unsigned char* ob = (LAS unsigned char*)smem + AT_WSOFF + 2048 + wid * 4096;
#pragma unroll
      for (int r = 0; r < 16; ++r)
#pragma unroll
        for (int d0 = 0; d0 < 2; ++d0) *(LAS unsigned short*)(ob + crow(r, hi) * 128 + (d0 * 32 + r32) * 2) = (unsigned short)(cvtpk(o[d0][r], 0.f) & 0xffffu);
#pragma unroll
      for (int i = 0; i < 4; ++i) { const int row = (lane >> 3) + 8 * i, ch = lane & 7;
        const u32x4 w = *(const LAS u32x4*)(ob + row * 128 + ch * 16);
        const long idx = ((long)b * SEQ + qb * 256 + wid * 32 + row) * 512 + h * 64 + ch * 8;
        const u32x4 z = *(const u32x4*)(ZM + idx);
        u32x4 rr;
#pragma unroll
        for (int e = 0; e < 4; ++e) rr[e] = cvtpk(bflo(w[e]) * bflo(z[e]), bfhi(w[e]) * bfhi(z[e]));
        *(u32x4*)(A1 + idx) = rr; }
    }
    __syncthreads();
  }
}

__device__ void phase_final_norm(const Params& P) {
  const long gtid = (long)blockIdx.x * NTHREADS + otid(), gsz = (long)GRIDX * NTHREADS;
  const int lane = otid() & 63; const long wv = gtid >> 6, nwv = gsz >> 6;
  f32x4 g4[4];
#pragma unroll
  for (int c = 0; c < 4; ++c) g4[c] = *(const f32x4*)(P.final_g + c * 256 + lane * 4);
  for (long row = wv; row < NTOK; row += nwv) {
    const float* xr = (const float*)(P.ws + WS_PRE) + row * DM; float* orow = P.out + row * DM; f32x4 v[4]; float ss = 0.f;
#pragma unroll
    for (int c = 0; c < 4; ++c) { v[c] = *(const f32x4*)(xr + c * 256 + lane * 4); ss += v[c][0] * v[c][0] + v[c][1] * v[c][1] + v[c][2] * v[c][2] + v[c][3] * v[c][3]; }
    ss = wave_sum(ss);
    const float rs = rsqrtf(ss * (1.f / DM) + RMS_EPS);
#pragma unroll
    for (int c = 0; c < 4; ++c) *(f32x4*)(orow + c * 256 + lane * 4) = v[c] * rs * g4[c];
  }
}

__device__ __forceinline__ void fast_barrier(unsigned* ctr, const unsigned epoch, const unsigned ngrid) {
  asm volatile("s_waitcnt vmcnt(0)" ::: "memory");
  __syncthreads();
  if (threadIdx.x == 0) {
    __builtin_amdgcn_fence(__ATOMIC_RELEASE, "agent");
    asm volatile("s_waitcnt vmcnt(0)" ::: "memory");
    const unsigned target = epoch * ngrid;
    (void)__hip_atomic_fetch_add(ctr, 1u, __ATOMIC_RELAXED, __HIP_MEMORY_SCOPE_AGENT);
    while (__hip_atomic_load(ctr, __ATOMIC_RELAXED, __HIP_MEMORY_SCOPE_AGENT) < target) __builtin_amdgcn_s_sleep(1);
    __builtin_amdgcn_fence(__ATOMIC_ACQUIRE, "agent");
    asm volatile("s_waitcnt vmcnt(0)" ::: "memory");
  }
  __syncthreads();
}
#define XB_XCNT(j)  (64 * (j))
#define XB_XSUB(j)  (1024 + 64 * (j))
#define XB_XGEN(j)  (2048 + 64 * (j))
#define XB_TOP      3072
#define XB_TOPGEN   3136
constexpr int XB_WORDS = 3200;
constexpr int LDS_XB = LDS_BYTES - 16;
__device__ __forceinline__ unsigned xb_ld(unsigned* p)              { return __hip_atomic_load(p, __ATOMIC_RELAXED, __HIP_MEMORY_SCOPE_AGENT); }
__device__ __forceinline__ unsigned xb_add(unsigned* p, unsigned v) { return __hip_atomic_fetch_add(p, v, __ATOMIC_RELAXED, __HIP_MEMORY_SCOPE_AGENT); }
__device__ __forceinline__ unsigned xb_xcc_id() { return (unsigned)__builtin_amdgcn_s_getreg((3 << 11) | 20) & 0xFu; }
__device__ __forceinline__ void xcd_barrier(unsigned* bar, const unsigned ngrid) {
  asm volatile("s_waitcnt vmcnt(0)" ::: "memory");
  __syncthreads();
  if (threadIdx.x == 0) {
    volatile LAS unsigned* st = (volatile LAS unsigned*)((LAS unsigned char*)smem + LDS_XB);
    const unsigned x = xb_xcc_id();
    unsigned nloc = st[0], nx = st[1];
    if (nloc == 0u) {
      for (;;) { unsigned sum = 0u, cnt = 0u, mine = 0u;
#pragma unroll
        for (unsigned j = 0; j < 16; ++j) { const unsigned c = xb_ld(&bar[XB_XCNT(j)]); sum += c; cnt += (c > 0u) ? 1u : 0u; mine = (j == x) ? c : mine; }
        if (sum == ngrid) { nloc = mine; nx = cnt; break; }
        __builtin_amdgcn_s_sleep(1); }
      st[0] = nloc; st[1] = nx;
    }
    const unsigned old = xb_add(&bar[XB_XSUB(x)], 1u);
    const unsigned gen = old / nloc;
    if (old + 1u == (gen + 1u) * nloc) {
      __builtin_amdgcn_fence(__ATOMIC_RELEASE, "agent");
      asm volatile("s_waitcnt vmcnt(0)" ::: "memory");
      const unsigned og = xb_add(&bar[XB_TOP], 1u);
      const unsigned tg = og / nx;
      if (og + 1u == (tg + 1u) * nx) xb_add(&bar[XB_TOPGEN], 1u);
      else while (xb_ld(&bar[XB_TOPGEN]) == tg) __builtin_amdgcn_s_sleep(1);
      __builtin_amdgcn_fence(__ATOMIC_ACQUIRE, "agent");
      xb_add(&bar[XB_XGEN(x)], 1u);
      asm volatile("s_waitcnt vmcnt(0)" ::: "memory");
    } else {
      while (xb_ld(&bar[XB_XGEN(x)]) == gen) __builtin_amdgcn_s_sleep(1);
      __builtin_amdgcn_fence(__ATOMIC_ACQUIRE, "agent");
      asm volatile("s_waitcnt vmcnt(0)" ::: "memory");
    }
  }
  __syncthreads();
}
constexpr int N_PHASES = 11;
template <int PH>
__device__ __forceinline__ void run_phase(const Params& P) {
  unsigned char* ws = P.ws;
  const bf16_t* H = (const bf16_t*)P.out;
  if constexpr (PH == 0) phase_prep(P);
  else if constexpr (PH == 1) phase_gemm<M_IN>(P, H, (const bf16_t*)(ws + WS_WIN), 1024, 12, 20, 12);
  else if constexpr (PH == 2) phase_dilated(P);
  else if constexpr (PH == 3) phase_combine(P);
  else if constexpr (PH == 4) phase_gemm<M_IN>(P, H, (const bf16_t*)(ws + WS_WIN), 1024, 0, 12, 0);
  else if constexpr (PH == 5) {
    phase_gemm<M_UQ>(P, (const bf16_t*)(ws + WS_CQ), (const bf16_t*)(ws + WS_WUQ), 256, 0, 4, 0);
    phase_gemm<M_UKV>(P, (const bf16_t*)(ws + WS_CKVR), (const bf16_t*)(ws + WS_WUKV), 256, 0, 4, 0);
    phase_kpe(P);
  }
  else if constexpr (PH == 6) phase_mla(P);
  else if constexpr (PH == 7) phase_gemm<M_OUT1>(P, (const bf16_t*)(ws + WS_A1), (const bf16_t*)(ws + WS_WOM), 512, 0, 4, 0);
  else if constexpr (PH == 8) phase_gemm<M_OUT2>(P, (const bf16_t*)(ws + WS_A2), (const bf16_t*)(ws + WS_WOD), 512, 0, 4, 0);
  else if constexpr (PH == 9) phase_gemm<M_FINAL>(P, (const bf16_t*)(ws + WS_MERGED), (const bf16_t*)(ws + WS_WOUT), 1024, 0, 4, 0);
  else phase_final_norm(P);
}

#if defined(__HIP_DEVICE_COMPILE__)
__device__ __forceinline__ Params load_params() {
  auto kp = __builtin_amdgcn_kernarg_segment_ptr();
  asm volatile("" : "+s"(kp));
  return *(const __attribute__((address_space(4))) Params*)kp;
}
#else
__device__ __forceinline__ Params load_params() { return Params{}; }
#endif
#if N_LAUNCH_PER_PHASE
template <int PH>
__global__ void __launch_bounds__(NTHREADS) k_phase(Params P) { run_phase<PH>(P); }
#else
__global__ void __launch_bounds__(NTHREADS) k_mega(Params P) {
  cg::grid_group grid = cg::this_grid();
  if (P.ws == nullptr) grid.sync();
#define SEAM(e)  do { const Params Q = load_params(); xcd_barrier((unsigned*)((unsigned char*)Q.out + OUT_BAR_OFF), (unsigned)Q.ngrid); } while (0)
  if (threadIdx.x == 0) { volatile LAS unsigned* st = (volatile LAS unsigned*)((LAS unsigned char*)smem + LDS_XB); st[0] = 0u; st[1] = 0u;
    (void)xb_add((unsigned*)((unsigned char*)P.out + OUT_BAR_OFF) + XB_XCNT(xb_xcc_id()), 1u); }
  __syncthreads();
#define SEAMB(e) do { const Params Q = load_params(); xcd_barrier((unsigned*)(Q.ws + WS_COS), (unsigned)Q.ngrid); } while (0)
#define RUN(k)   do { const Params Q = load_params(); run_phase<k>(Q); } while (0)
  run_phase<0>(P); SEAM(1);
  RUN(1); SEAM(2);
  RUN(2); SEAM(3);
  RUN(3); SEAM(4);
  RUN(4); SEAM(5);
  RUN(5); SEAM(6);
  if (blockIdx.x == 0) { const Params Q = load_params(); const int t = otid();
    for (int w = t; w < XB_WORDS; w += NTHREADS) __hip_atomic_store((unsigned*)(Q.ws + WS_COS) + w, 0u, __ATOMIC_RELAXED, __HIP_MEMORY_SCOPE_AGENT);
    if (t < 128) __hip_atomic_store((unsigned*)(Q.ws + WS_SIN) + t, 0u, __ATOMIC_RELAXED, __HIP_MEMORY_SCOPE_AGENT); }
  RUN(6); SEAM(7);
  { const Params Q = load_params();
    phase_gemm<M_OUT12>(Q, (const bf16_t*)(Q.ws + WS_A1), (const bf16_t*)(Q.ws + WS_WOM), 512, 0, 4, 0); }
  SEAMB(1);
  { const Params Q = load_params();
    phase_gemm<M_FINALN>(Q, (const bf16_t*)(Q.ws + WS_MERGED), (const bf16_t*)(Q.ws + WS_WOUT), 1024, 0, 4, 0); }
}
#endif

template <int PH> static void launch_phase(const Params& p, int grid, hipStream_t stream) {
#if N_LAUNCH_PER_PHASE
  static bool attr = false;
  if (!attr) { (void)hipFuncSetAttribute((const void*)k_phase<PH>, hipFuncAttributeMaxDynamicSharedMemorySize, LDS_BYTES); attr = true; }
  hipLaunchKernelGGL(k_phase<PH>, dim3(grid), dim3(NTHREADS), LDS_BYTES, stream, p);
#endif
}

extern "C" void kernel_launch(void* const* d_in, const int* in_sizes, int n_in, void* d_out, int out_size, void* d_ws, size_t ws_size, hipStream_t stream) {
  static int grid = 0;
  if (grid == 0) {
    if (n_in != 13 || in_sizes[0] != NTOK * DM || out_size != NTOK * DM || ws_size < WS_END) {
      fprintf(stderr, "kernel_launch: unexpected shapes (n_in %d, in0 %d, out %d, ws %zu)\n", n_in, n_in > 0 ? in_sizes[0] : -1, out_size, ws_size); grid = -1; return; }
    int dev = 0, cus = 0;
    (void)hipGetDevice(&dev); (void)hipDeviceGetAttribute(&cus, hipDeviceAttributeMultiprocessorCount, dev);
#if N_LAUNCH_PER_PHASE
    grid = cus > 0 ? cus : 256;
#else
    int per_cu = 0;
    if (hipFuncSetAttribute((const void*)k_mega, hipFuncAttributeMaxDynamicSharedMemorySize, LDS_BYTES) != hipSuccess) { fprintf(stderr, "kernel_launch: hipFuncSetAttribute failed\n"); grid = -1; return; }
    if (hipOccupancyMaxActiveBlocksPerMultiprocessor(&per_cu, (const void*)k_mega, NTHREADS, LDS_BYTES) != hipSuccess || per_cu < 1) { fprintf(stderr, "kernel_launch: occupancy query failed (%d)\n", per_cu); grid = -1; return; }
    grid = cus;
    if (grid % 4 != 0) { fprintf(stderr, "kernel_launch: %d CUs: the fused final-norm exchange needs a grid that is a multiple of 4\n", grid); grid = -1; return; }
#endif
  }
  if (grid < 0) return;
  Params p{};
  p.x = (const float*)d_in[0]; p.pos = (const int*)d_in[1]; p.attn_g = (const float*)d_in[2]; p.w_in = (const float*)d_in[3]; p.b_gate = (const float*)d_in[4];
  p.gq = (const float*)d_in[5]; p.gkv = (const float*)d_in[6]; p.w_uq = (const float*)d_in[7]; p.w_ukv = (const float*)d_in[8]; p.w_om = (const float*)d_in[9];
  p.w_od = (const float*)d_in[10]; p.w_out = (const float*)d_in[11]; p.final_g = (const float*)d_in[12];
  p.out = (float*)d_out; p.ws = (unsigned char*)d_ws;
  for (int i = 0; i < 32; ++i) p.inv_freq[i] = powf(10000.0f, -(float)(2 * i) / 64.0f);
  p.ngrid = grid;
#if N_LAUNCH_PER_PHASE
  launch_phase<0>(p, grid, stream); launch_phase<1>(p, grid, stream); launch_phase<2>(p, grid, stream); launch_phase<3>(p, grid, stream);
  launch_phase<4>(p, grid, stream); launch_phase<5>(p, grid, stream); launch_phase<6>(p, grid, stream); launch_phase<7>(p, grid, stream);
  launch_phase<8>(p, grid, stream); launch_phase<9>(p, grid, stream); launch_phase<10>(p, grid, stream);
#else
  (void)hipMemsetAsync((unsigned char*)d_out + OUT_BAR_OFF, 0, XB_WORDS * 4, stream);
  void* args[] = {&p};
  hipError_t e = hipLaunchCooperativeKernel((const void*)k_mega, dim3(grid), dim3(NTHREADS), args, LDS_BYTES, stream);
  if (e != hipSuccess) fprintf(stderr, "cooperative launch failed: %s (grid %d)\n", hipGetErrorString(e), grid);
#endif
}
```

```cpp
#include <hip/hip_runtime.h>
#include <hip/hip_cooperative_groups.h>
#include <cstdio>
#include <cstdint>
#include <cmath>
namespace cg = cooperative_groups;

#ifndef N_LAUNCH_PER_PHASE
#define N_LAUNCH_PER_PHASE 0
#endif

#define LAS __attribute__((address_space(3)))
typedef unsigned short bf16_t;
using bf16x8 = __attribute__((ext_vector_type(8))) short;
using s16x4  = __attribute__((ext_vector_type(4))) short;
using f32x4  = __attribute__((ext_vector_type(4))) float;
using f32x16 = __attribute__((ext_vector_type(16))) float;
using u32x4  = __attribute__((ext_vector_type(4))) unsigned;
using u32x2  = __attribute__((ext_vector_type(2))) unsigned;

constexpr int SEQ = 8192, NBATCH = 4, DM = 1024, NTOK = NBATCH * SEQ, INW = 8096;
constexpr int NTHREADS = 512;
constexpr float RMS_EPS = 1e-6f;
constexpr float LOG2E = 1.4426950408889634f;
constexpr size_t MiB = 1ull << 20;
constexpr size_t WS_WIN = 0, WS_WUQ = 16 * MiB, WS_WUKV = WS_WUQ + MiB / 2, WS_WOM = 17 * MiB, WS_WOD = 18 * MiB, WS_WOUT = 19 * MiB,
                 WS_LSE = 21 * MiB, WS_COS = 24 * MiB, WS_SIN = 28 * MiB, WS_ZD = 32 * MiB, WS_A2 = 64 * MiB, WS_A1 = 96 * MiB,
                 WS_QD = 128 * MiB, WS_KD = 224 * MiB, WS_VD = 320 * MiB, WS_OG = 416 * MiB, WS_END = 512 * MiB,
                 WS_CQ = 128 * MiB, WS_CKVR = 144 * MiB, WS_ZM = 160 * MiB, WS_MQ = 192 * MiB, WS_MK = 240 * MiB, WS_MV = 288 * MiB,
                 WS_GM = 320 * MiB, WS_GD = 384 * MiB, WS_MERGED = 128 * MiB, WS_PRE = 192 * MiB;
constexpr size_t OUT_BAR_OFF = 64 * MiB;
constexpr int EPI_ROWB = 520;
constexpr int LDS_MISC = 256 * EPI_ROWB;
constexpr int LDS_BYTES = LDS_MISC + 2048;

struct Params {
  const float* x; const int* pos; const float* attn_g; const float* w_in; const float* b_gate; const float* gq; const float* gkv;
  const float* w_uq; const float* w_ukv; const float* w_om; const float* w_od; const float* w_out; const float* final_g;
  float* out; unsigned char* ws;
  float inv_freq[32];
  int ngrid; int pad_;
};

extern __shared__ __attribute__((aligned(16))) unsigned char smem[];

#define LOG2E_F 1.4426950408889634f
__device__ __forceinline__ unsigned cvtpk(float lo, float hi) {
  typedef float f32x2_t __attribute__((ext_vector_type(2))); typedef __bf16 bf16x2_t __attribute__((ext_vector_type(2)));
  const f32x2_t v = {lo, hi}; const bf16x2_t r = __builtin_convertvector(v, bf16x2_t); return __builtin_bit_cast(unsigned, r);
}
__device__ __forceinline__ void st16_wt(void* p, u32x4 v) { asm volatile("global_store_dwordx4 %0, %1, off sc1\n\ts_nop 1" :: "v"(p), "v"(v) : "memory"); }
__device__ __forceinline__ float bf2f(unsigned short v) { return __uint_as_float(((unsigned)v) << 16); }
__device__ __forceinline__ float bflo(unsigned w) { return __uint_as_float(w << 16); }
__device__ __forceinline__ float bfhi(unsigned w) { return __uint_as_float(w & 0xffff0000u); }
__device__ __forceinline__ float sigmoidf_(float v) { return __builtin_amdgcn_rcpf(1.f + __builtin_amdgcn_exp2f(-LOG2E_F * v)); }
__device__ __forceinline__ float wave_sum(float v) {
#pragma unroll
  for (int o = 32; o > 0; o >>= 1) v += __shfl_xor(v, o);
  return v;
}
__device__ __forceinline__ int otid() { int t = threadIdx.x; asm volatile("" : "+v"(t)); return t; }
#define GRIDX (P.ngrid)
__device__ __forceinline__ int vcu_id_(const int G) { const int bx = blockIdx.x; return (G % 8 == 0) ? (bx % 8) * (G / 8) + bx / 8 : bx; }

constexpr int BK = 64, HTB = 128 * BK * 2;
__device__ __forceinline__ int lds_byte(int r, int c) {
  int st = (r >> 4) * 2 + (c >> 5), rr = r & 15, cc = c & 31, ob = rr * 64 + cc * 2;
  return st * 1024 + (ob ^ (((ob >> 9) & 1) << 5));
}
__device__ __forceinline__ void stage_rc(int b, int& R, int& C) {
  int st = b / 1024, sb = b % 1024, swz = sb ^ (((sb >> 9) & 1) << 5);
  R = (st >> 1) * 16 + swz / 64; C = (st & 1) * 32 + (swz % 64) / 2;
}

enum { M_IN = 0, M_UQ = 1, M_UKV = 2, M_OUT1 = 3, M_OUT2 = 4, M_FINAL = 5, M_FINALN = 6, M_OUT12 = 7 };

__device__ __forceinline__ void st4bf(bf16_t* p, f32x4 v) { u32x2 w; w.x = cvtpk(v[0], v[1]); w.y = cvtpk(v[2], v[3]); *(u32x2*)p = w; }

template <int TYPE>
__device__ __forceinline__ void epi_in(const Params& P, const f32x4 (&acc)[2][2][4][2], bf16_t* dst, const int ld, const int col0, const float* bias, const float qs,
                                       const int pm, const int wr, const int wc, const int fr, const int fq) {
  LAS unsigned char* lds = (LAS unsigned char*)smem;
  const float* cosT = (const float*)(P.ws + WS_COS); const float* sinT = (const float*)(P.ws + WS_SIN);
  const int fi = (wc & 1) * 16 + fq * 4;
  f32x4 csA[4], snA[4], bbA[2][2];
  if constexpr (TYPE == 2) {
#pragma unroll
    for (int bj = 0; bj < 2; ++bj) { const int lc = (bj * 2 + (wc >> 1)) * 64 + fi; bbA[bj][0] = *(const f32x4*)(bias + lc); bbA[bj][1] = *(const f32x4*)(bias + lc + 32); }
  }
#pragma unroll
  for (int ai = 0; ai < 2; ++ai) {
    if constexpr (TYPE == 3) {
#pragma unroll
      for (int m = 0; m < 4; ++m) { const size_t row = (size_t)(pm * 256 + ai * 128 + wr * 64 + m * 16 + fr);
        csA[m] = *(const f32x4*)(cosT + row * 32 + fi); snA[m] = *(const f32x4*)(sinT + row * 32 + fi); }
    }
#pragma unroll
    for (int m = 0; m < 4; ++m) {
      const int lr = ai * 128 + wr * 64 + m * 16 + fr;
      f32x4 cs = {1.f, 1.f, 1.f, 1.f}, sn = {0.f, 0.f, 0.f, 0.f};
      if constexpr (TYPE == 3) { cs = csA[m]; sn = snA[m]; }
#pragma unroll
      for (int bj = 0; bj < 2; ++bj) {
        const int lc = (bj * 2 + (wc >> 1)) * 64 + fi;
        f32x4 v0 = acc[ai][bj][m][0], v1 = acc[ai][bj][m][1];
        if constexpr (TYPE == 1) {
#pragma unroll
          for (int j = 0; j < 4; ++j) { v0[j] = v0[j] * sigmoidf_(v0[j]); v1[j] = v1[j] * sigmoidf_(v1[j]); }
        } else if constexpr (TYPE == 2) {
          const f32x4 b0 = bbA[bj][0], b1 = bbA[bj][1];
#pragma unroll
          for (int j = 0; j < 4; ++j) { v0[j] = sigmoidf_(v0[j] + b0[j]); v1[j] = sigmoidf_(v1[j] + b1[j]); }
        } else if constexpr (TYPE == 3) {
#pragma unroll
          for (int j = 0; j < 4; ++j) { const float a = v0[j], b = v1[j]; v0[j] = (a * cs[j] - b * sn[j]) * qs; v1[j] = (b * cs[j] + a * sn[j]) * qs; }
        }
        u32x2 w0, w1; w0.x = cvtpk(v0[0], v0[1]); w0.y = cvtpk(v0[2], v0[3]); w1.x = cvtpk(v1[0], v1[1]); w1.y = cvtpk(v1[2], v1[3]);
        *(LAS u32x2*)(lds + lr * EPI_ROWB + lc * 2) = w0;
        *(LAS u32x2*)(lds + lr * EPI_ROWB + lc * 2 + 64) = w1;
      }
    }
  }
  __syncthreads();
  const int t = otid();
  bf16_t* drow = dst + (size_t)pm * 256 * ld + col0;
#pragma unroll 4
  for (int i = 0; i < 16; ++i) {
    const int ch = t + 512 * i, r = ch >> 5, cc = ch & 31;
    const u32x2 a = *(const LAS u32x2*)(lds + r * EPI_ROWB + cc * 16), b = *(const LAS u32x2*)(lds + r * EPI_ROWB + cc * 16 + 8);
    u32x4 w = {a.x, a.y, b.x, b.y};
    st16_wt(drow + (size_t)r * ld + cc * 8, w);
  }
}

template <int MODE>
__device__ __forceinline__ void gemm_epilogue(const Params& P, f32x4 (&acc)[2][2][4][2], const int pm, const int pn, const int wr, const int wc, const int fr, const int fq) {
  unsigned char* ws = P.ws;
  const int row0 = pm * 256 + wr * 64 + fr;
  if constexpr (MODE == M_IN) {
    if (pn == 0)      epi_in<0>(P, acc, (bf16_t*)(ws + WS_CQ),   256,  0,               nullptr, 1.f, pm, wr, wc, fr, fq);
    else if (pn == 1) epi_in<0>(P, acc, (bf16_t*)(ws + WS_CKVR), 256,  0,               nullptr, 1.f, pm, wr, wc, fr, fq);
    else if (pn < 4)  epi_in<1>(P, acc, (bf16_t*)(ws + WS_ZM),   512,  (pn - 2) * 256,  nullptr, 1.f, pm, wr, wc, fr, fq);
    else if (pn < 8)  epi_in<2>(P, acc, (bf16_t*)(ws + WS_GM),   1024, (pn - 4) * 256,  P.b_gate + (pn - 4) * 256, 1.f, pm, wr, wc, fr, fq);
    else if (pn < 12) epi_in<2>(P, acc, (bf16_t*)(ws + WS_GD),   1024, (pn - 8) * 256,  P.b_gate + 1024 + (pn - 8) * 256, 1.f, pm, wr, wc, fr, fq);
    else if (pn < 18) epi_in<3>(P, acc, (bf16_t*)(ws + WS_QD),   1536, (pn - 12) * 256, nullptr, 0.125f, pm, wr, wc, fr, fq);
    else if (pn < 24) epi_in<3>(P, acc, (bf16_t*)(ws + WS_KD),   1536, (pn - 18) * 256, nullptr, 1.f, pm, wr, wc, fr, fq);
    else if (pn < 30) epi_in<0>(P, acc, (bf16_t*)(ws + WS_VD),   1536, (pn - 24) * 256, nullptr, 1.f, pm, wr, wc, fr, fq);
    else              epi_in<1>(P, acc, (bf16_t*)(ws + WS_ZD),   512,  (pn - 30) * 256, nullptr, 1.f, pm, wr, wc, fr, fq);
  } else if constexpr (MODE == M_UQ || MODE == M_UKV) {
    const LAS float* rstd = (const LAS float*)((LAS unsigned char*)smem + LDS_MISC);
    LAS unsigned char* ldsE = (LAS unsigned char*)smem;
    const float* cosT = (const float*)(ws + WS_COS); const float* sinT = (const float*)(ws + WS_SIN);
    bf16_t* MQ = (bf16_t*)(ws + WS_MQ); bf16_t* MK = (bf16_t*)(ws + WS_MK); bf16_t* MV = (bf16_t*)(ws + WS_MV);
    f32x4 cA[4][2], sA[4][2];
#pragma unroll
    for (int ai = 0; ai < 2; ++ai) {
      if constexpr (MODE == M_UQ) { if (wc == 2) {
#pragma unroll
        for (int m = 0; m < 4; ++m) { const size_t row = (size_t)(pm * 256 + ai * 128 + wr * 64 + m * 16 + fr);
          cA[m][0] = *(const f32x4*)(cosT + row * 32 + fq * 8); cA[m][1] = *(const f32x4*)(cosT + row * 32 + fq * 8 + 4);
          sA[m][0] = *(const f32x4*)(sinT + row * 32 + fq * 8); sA[m][1] = *(const f32x4*)(sinT + row * 32 + fq * 8 + 4); }
      } }
#pragma unroll
      for (int m = 0; m < 4; ++m) {
        const int lr = ai * 128 + wr * 64 + m * 16 + fr;
        const int row = pm * 256 + lr;
        const int b = row / SEQ, s = row % SEQ;
        const float rs = rstd[lr];
#pragma unroll
        for (int bj = 0; bj < 2; ++bj) {
          const int head = 2 * pn + bj;
          f32x4 v0 = acc[ai][bj][m][0] * rs, v1 = acc[ai][bj][m][1] * rs;
          const size_t hrow = (size_t)(b * 8 + head) * SEQ + s;
          (void)hrow;
          if constexpr (MODE == M_UQ) { if (wc == 2) {
#pragma unroll
              for (int j = 0; j < 4; ++j) {
                const float c = cA[m][j >> 1][(j & 1) * 2], sn = sA[m][j >> 1][(j & 1) * 2];
                const float a = v0[j], bb = v1[j]; v0[j] = a * c - bb * sn; v1[j] = bb * c + a * sn;
              } } }
          if (MODE == M_UKV || wc < 3) {
            u32x2 w0, w1; w0.x = cvtpk(v0[0], v0[1]); w0.y = cvtpk(v0[2], v0[3]); w1.x = cvtpk(v1[0], v1[1]); w1.y = cvtpk(v1[2], v1[3]);
            const int ic = bj * 128 + wc * 32 + fq * 4;
            *(LAS u32x2*)(ldsE + lr * EPI_ROWB + ic * 2) = w0; *(LAS u32x2*)(ldsE + lr * EPI_ROWB + ic * 2 + 32) = w1;
          }
        }
      }
    }
    __syncthreads();
    {
      const int t = otid();
      const int b = (pm * 256) / SEQ, s0 = (pm * 256) % SEQ;
      constexpr int CPR = (MODE == M_UQ) ? 24 : 32;
#pragma unroll 4
      for (int i = 0; i < CPR / 2; ++i) {
        const int ch = t + 512 * i, r = ch / CPR, c = ch % CPR;
        int hh, icol; bf16_t* dst;
        if constexpr (MODE == M_UQ) { hh = c / 12; const int cc = c % 12; icol = hh * 128 + cc * 8; dst = MQ + ((size_t)(b * 8 + 2 * pn + hh) * SEQ + s0 + r) * 96 + cc * 8; }
        else { hh = c >> 4; const int cc = c & 15; icol = hh * 128 + cc * 8;
          dst = (cc < 8) ? MK + ((size_t)(b * 8 + 2 * pn + hh) * SEQ + s0 + r) * 96 + cc * 8 : MV + ((size_t)(b * 8 + 2 * pn + hh) * SEQ + s0 + r) * 64 + (cc - 8) * 8; }
        const u32x2 a = *(const LAS u32x2*)(ldsE + r * EPI_ROWB + icol * 2), bq = *(const LAS u32x2*)(ldsE + r * EPI_ROWB + icol * 2 + 8);
        *(u32x4*)dst = (u32x4){a.x, a.y, bq.x, bq.y};
      }
    }
  } else if constexpr (MODE == M_OUT1 || MODE == M_OUT2) {
    const bf16_t* G = (const bf16_t*)(ws + (MODE == M_OUT1 ? WS_GM : WS_GD));
    bf16_t* Mg = (bf16_t*)(ws + WS_MERGED);
#pragma unroll
    for (int ai = 0; ai < 2; ++ai) {
      u32x2 gA[4][2][2], tA[4][2][2];
#pragma unroll
      for (int m = 0; m < 4; ++m)
#pragma unroll
        for (int bj = 0; bj < 2; ++bj)
#pragma unroll
          for (int n = 0; n < 2; ++n) {
            const size_t idx = (size_t)(row0 + ai * 128 + m * 16) * 1024 + pn * 256 + bj * 128 + wc * 32 + n * 16 + fq * 4;
            gA[m][bj][n] = *(const u32x2*)(G + idx);
            if constexpr (MODE == M_OUT2) tA[m][bj][n] = *(const u32x2*)(Mg + idx);
          }
#pragma unroll
      for (int m = 0; m < 4; ++m)
#pragma unroll
        for (int bj = 0; bj < 2; ++bj)
#pragma unroll
          for (int n = 0; n < 2; ++n) {
            const size_t idx = (size_t)(row0 + ai * 128 + m * 16) * 1024 + pn * 256 + bj * 128 + wc * 32 + n * 16 + fq * 4;
            const u32x2 g = gA[m][bj][n];
            f32x4 v = acc[ai][bj][m][n];
            v[0] *= bflo(g.x); v[1] *= bfhi(g.x); v[2] *= bflo(g.y); v[3] *= bfhi(g.y);
            if constexpr (MODE == M_OUT2) { const u32x2 t = tA[m][bj][n]; v[0] += bflo(t.x); v[1] += bfhi(t.x); v[2] += bflo(t.y); v[3] += bfhi(t.y); }
            st4bf(Mg + idx, v);
          }
    }
  } else if constexpr (MODE == M_OUT12) {
    const bf16_t* GDp = (const bf16_t*)(ws + WS_GD); bf16_t* Mg = (bf16_t*)(ws + WS_MERGED);
#pragma unroll
    for (int ai = 0; ai < 2; ++ai) {
      u32x2 gdA[4][2][2];
#pragma unroll
      for (int m = 0; m < 4; ++m)
#pragma unroll
        for (int bj = 0; bj < 2; ++bj)
#pragma unroll
          for (int n = 0; n < 2; ++n) gdA[m][bj][n] = *(const u32x2*)(GDp + (size_t)(row0 + ai * 128 + m * 16) * 1024 + pn * 256 + bj * 128 + wc * 32 + n * 16 + fq * 4);
#pragma unroll
      for (int m = 0; m < 4; ++m)
#pragma unroll
        for (int bj = 0; bj < 2; ++bj)
#pragma unroll
          for (int n = 0; n < 2; ++n) {
            const size_t idx = (size_t)(row0 + ai * 128 + m * 16) * 1024 + pn * 256 + bj * 128 + wc * 32 + n * 16 + fq * 4;
            const u32x2 gd = gdA[m][bj][n]; f32x4 v = acc[ai][bj][m][n];
            v[0] *= fmaxf(bflo(gd.x), 1e-30f); v[1] *= fmaxf(bfhi(gd.x), 1e-30f); v[2] *= fmaxf(bflo(gd.y), 1e-30f); v[3] *= fmaxf(bfhi(gd.y), 1e-30f);
            st4bf(Mg + idx, v);
          }
    }
  } else if constexpr (MODE == M_FINALN) {
    LAS unsigned char* lds = (LAS unsigned char*)smem;
    LAS float* part = (LAS float*)lds;
    LAS float* rstdL = (LAS float*)(lds + 4096);
    float* stats = (float*)(ws + WS_ZD);
    unsigned* pctr = (unsigned*)(ws + WS_SIN);
    const int tid = otid();
#pragma unroll
    for (int ai = 0; ai < 2; ++ai)
#pragma unroll
      for (int mh = 0; mh < 2; ++mh) {
        f32x4 xA[2][2][2];
#pragma unroll
        for (int mm = 0; mm < 2; ++mm)
#pragma unroll
          for (int bj = 0; bj < 2; ++bj)
#pragma unroll
            for (int n = 0; n < 2; ++n) {
              const size_t idx = (size_t)(row0 + ai * 128 + (mh * 2 + mm) * 16) * 1024 + pn * 256 + bj * 128 + wc * 32 + n * 16 + fq * 4;
              xA[mm][bj][n] = __builtin_nontemporal_load((const f32x4*)(P.x + idx));
            }
#pragma unroll
        for (int mm = 0; mm < 2; ++mm) {
          float sq = 0.f;
#pragma unroll
          for (int bj = 0; bj < 2; ++bj)
#pragma unroll
            for (int n = 0; n < 2; ++n) { f32x4 v = acc[ai][bj][mh * 2 + mm][n] + xA[mm][bj][n]; acc[ai][bj][mh * 2 + mm][n] = v;
              sq += v[0] * v[0] + v[1] * v[1] + v[2] * v[2] + v[3] * v[3]; }
          sq += __shfl_xor(sq, 16); sq += __shfl_xor(sq, 32);
          if (fq == 0) part[(ai * 128 + wr * 64 + (mh * 2 + mm) * 16 + fr) * 4 + wc] = sq;
        }
      }
    __syncthreads();
    if (tid < 256) __hip_atomic_store((unsigned*)stats + ((size_t)pm * 4 + pn) * 256 + tid,
                                      __float_as_uint((part[tid * 4 + 0] + part[tid * 4 + 1]) + (part[tid * 4 + 2] + part[tid * 4 + 3])), __ATOMIC_RELAXED, __HIP_MEMORY_SCOPE_AGENT);
    asm volatile("s_waitcnt vmcnt(0)" ::: "memory");
    __syncthreads();
    if (tid == 0) {
      (void)__hip_atomic_fetch_add(pctr + pm, 1u, __ATOMIC_RELAXED, __HIP_MEMORY_SCOPE_AGENT);
      while (__hip_atomic_load(pctr + pm, __ATOMIC_RELAXED, __HIP_MEMORY_SCOPE_AGENT) < 4u) __builtin_amdgcn_s_sleep(1);
    }
    __syncthreads();
    if (tid < 256) {
      unsigned* sp = (unsigned*)stats + (size_t)pm * 4 * 256 + tid;
      const float t0 = __uint_as_float(__hip_atomic_load(sp, __ATOMIC_RELAXED, __HIP_MEMORY_SCOPE_AGENT)), t1 = __uint_as_float(__hip_atomic_load(sp + 256, __ATOMIC_RELAXED, __HIP_MEMORY_SCOPE_AGENT));
      const float t2 = __uint_as_float(__hip_atomic_load(sp + 512, __ATOMIC_RELAXED, __HIP_MEMORY_SCOPE_AGENT)), t3 = __uint_as_float(__hip_atomic_load(sp + 768, __ATOMIC_RELAXED, __HIP_MEMORY_SCOPE_AGENT));
      rstdL[tid] = rsqrtf(((t0 + t1) + (t2 + t3)) * (1.f / DM) + RMS_EPS);
    }
    __syncthreads();
#pragma unroll
    for (int bj = 0; bj < 2; ++bj)
#pragma unroll
      for (int n = 0; n < 2; ++n) {
        const int col = pn * 256 + bj * 128 + wc * 32 + n * 16 + fq * 4;
        const f32x4 g4 = *(const f32x4*)(P.final_g + col);
#pragma unroll
        for (int ai = 0; ai < 2; ++ai)
#pragma unroll
          for (int m = 0; m < 4; ++m) {
            const int lr = ai * 128 + wr * 64 + m * 16 + fr;
            *(f32x4*)(P.out + (size_t)(pm * 256 + lr) * 1024 + col) = acc[ai][bj][m][n] * rstdL[lr] * g4;
          }
      }
  } else {
#pragma unroll
    for (int ai = 0; ai < 2; ++ai)
#pragma unroll
      for (int mh = 0; mh < 2; ++mh) {
        f32x4 xA[2][2][2];
#pragma unroll
        for (int mm = 0; mm < 2; ++mm)
#pragma unroll
          for (int bj = 0; bj < 2; ++bj)
#pragma unroll
            for (int n = 0; n < 2; ++n) {
              const size_t idx = (size_t)(row0 + ai * 128 + (mh * 2 + mm) * 16) * 1024 + pn * 256 + bj * 128 + wc * 32 + n * 16 + fq * 4;
              xA[mm][bj][n] = __builtin_nontemporal_load((const f32x4*)(P.x + idx));
            }
#pragma unroll
        for (int mm = 0; mm < 2; ++mm)
#pragma unroll
          for (int bj = 0; bj < 2; ++bj)
#pragma unroll
            for (int n = 0; n < 2; ++n) {
              const size_t idx = (size_t)(row0 + ai * 128 + (mh * 2 + mm) * 16) * 1024 + pn * 256 + bj * 128 + wc * 32 + n * 16 + fq * 4;
              *(f32x4*)((float*)(ws + WS_PRE) + idx) = acc[ai][bj][mh * 2 + mm][n] + xA[mm][bj][n];
            }
      }
  }
}

template <int MODE>
__device__ __forceinline__ void gemm_tile(const Params& P, const bf16_t* __restrict__ A, const bf16_t* __restrict__ Bt, const int K, const int pm, const int pnb, const int pn_epi) {
  LAS unsigned char* lds = (LAS unsigned char*)smem;
  const int tid = otid(), wid = __builtin_amdgcn_readfirstlane(tid >> 6), lane = tid & 63, wr = wid >> 2, wc = wid & 3, fr = lane & 15, fq = lane >> 4;
  const int brow = pm * 256, bcol = pnb * 256;
  __syncthreads();
  if constexpr (MODE == M_UQ || MODE == M_UKV) {
    constexpr int NC = (MODE == M_UQ) ? 256 : 128;
    const int r = tid >> 1, hf = tid & 1;
    const bf16_t* ap = A + (size_t)(brow + r) * K + hf * (NC / 2);
    float ss = 0.f;
#pragma unroll
    for (int i = 0; i < NC / 16; ++i) {
      const u32x4 w = *(const u32x4*)(ap + i * 8);
#pragma unroll
      for (int e = 0; e < 4; ++e) { const float a = bflo(w[e]), b = bfhi(w[e]); ss += a * a + b * b; }
    }
    ss += __shfl_xor(ss, 1);
    if (hf == 0) ((LAS float*)(lds + LDS_MISC))[r] = rsqrtf(ss * (1.f / NC) + RMS_EPS);
  }
  unsigned goff[2];
  { int R, C; stage_rc(tid * 16, R, C); goff[0] = (unsigned)(R * K + C) * 2u; goff[1] = goff[0] + (unsigned)(64 * K) * 2u; }
#define SAO(b, h) (((b) * 2 + (h)) * HTB)
#define SBO(b, h) ((4 + (b) * 2 + (h)) * HTB)
#define STAGE(PO, BASE, br, kt) do { const char* _g = (const char*)((BASE) + (size_t)(br) * K + (size_t)(kt) * BK); \
    _Pragma("unroll") for (int _i = 0; _i < 2; ++_i) \
      __builtin_amdgcn_global_load_lds((const unsigned*)(_g + goff[_i]), (LAS unsigned*)(lds + (PO) + wid * 1024 + _i * 8192), 16, 0, 0); } while (0)
#define LDA(dst, b, h) _Pragma("unroll") for (int m = 0; m < 4; ++m) _Pragma("unroll") for (int k = 0; k < 2; ++k) \
    dst[m][k] = *(const LAS bf16x8*)(lds + SAO(b, h) + lds_byte(wr * 64 + m * 16 + fr, k * 32 + fq * 8))
#define LDB(dst, b, h) _Pragma("unroll") for (int n = 0; n < 2; ++n) _Pragma("unroll") for (int k = 0; k < 2; ++k) \
    dst[n][k] = *(const LAS bf16x8*)(lds + SBO(b, h) + lds_byte(wc * 32 + n * 16 + fr, k * 32 + fq * 8))
#define MMA(ai, bj, AT, BT) do { __builtin_amdgcn_s_setprio(1); \
    _Pragma("unroll") for (int m = 0; m < 4; ++m) _Pragma("unroll") for (int n = 0; n < 2; ++n) _Pragma("unroll") for (int k = 0; k < 2; ++k) \
      acc[ai][bj][m][n] = __builtin_amdgcn_mfma_f32_16x16x32_bf16(BT[n][k], AT[m][k], acc[ai][bj][m][n], 0, 0, 0); \
    __builtin_amdgcn_s_setprio(0); } while (0)
#define WAIT_V(n) asm volatile("s_waitcnt vmcnt(" #n ")" ::: "memory")
#define WAIT_L(n) asm volatile("s_waitcnt lgkmcnt(" #n ")" ::: "memory")
#define BAR __builtin_amdgcn_s_barrier()
#define SCHED __builtin_amdgcn_sched_barrier(0)
  f32x4 acc[2][2][4][2] = {};
  bf16x8 At[4][2], B0[2][2], B1[2][2];
  const int nt = K / BK;
  constexpr int NPASS = (MODE == M_OUT12) ? 2 : 1;
#pragma unroll 1
  for (int pass = 0; pass < NPASS; ++pass) {
  const bf16_t* Ap = A; const bf16_t* Bp = Bt;
  if constexpr (MODE == M_OUT12) { if (pass == 1) {
    Ap = (const bf16_t*)(P.ws + WS_A2); Bp = (const bf16_t*)(P.ws + WS_WOD);
    int l2 = lane; asm volatile("" : "+v"(l2)); const int fr2 = l2 & 15, fq2 = l2 >> 4;
    const bf16_t* GMp = (const bf16_t*)(P.ws + WS_GM); const bf16_t* GDp = (const bf16_t*)(P.ws + WS_GD);
#pragma unroll
    for (int ai = 0; ai < 2; ++ai) {
      u32x2 gmA[4][2][2], gdA[4][2][2];
#pragma unroll
      for (int m = 0; m < 4; ++m)
#pragma unroll
        for (int bj = 0; bj < 2; ++bj)
#pragma unroll
          for (int n = 0; n < 2; ++n) {
            const size_t idx = (size_t)(pm * 256 + wr * 64 + fr2 + ai * 128 + m * 16) * 1024 + pn_epi * 256 + bj * 128 + wc * 32 + n * 16 + fq2 * 4;
            gmA[m][bj][n] = *(const u32x2*)(GMp + idx); gdA[m][bj][n] = *(const u32x2*)(GDp + idx);
          }
#pragma unroll
      for (int m = 0; m < 4; ++m)
#pragma unroll
        for (int bj = 0; bj < 2; ++bj)
#pragma unroll
          for (int n = 0; n < 2; ++n) {
            const u32x2 gm = gmA[m][bj][n], gd = gdA[m][bj][n];
            acc[ai][bj][m][n][0] *= bflo(gm.x) * __builtin_amdgcn_rcpf(fmaxf(bflo(gd.x), 1e-30f));
            acc[ai][bj][m][n][1] *= bfhi(gm.x) * __builtin_amdgcn_rcpf(fmaxf(bfhi(gd.x), 1e-30f));
            acc[ai][bj][m][n][2] *= bflo(gm.y) * __builtin_amdgcn_rcpf(fmaxf(bflo(gd.y), 1e-30f));
            acc[ai][bj][m][n][3] *= bfhi(gm.y) * __builtin_amdgcn_rcpf(fmaxf(bfhi(gd.y), 1e-30f));
          }
    }
    __syncthreads();
  } }
  STAGE(SBO(0, 0), Bp, bcol, 0); STAGE(SAO(0, 0), Ap, brow, 0);
  STAGE(SBO(0, 1), Bp, bcol + 128, 0); STAGE(SAO(0, 1), Ap, brow + 128, 0);
  if (wr == 1) BAR;
  WAIT_V(4); BAR;
  STAGE(SBO(1, 0), Bp, bcol, 1); STAGE(SAO(1, 0), Ap, brow, 1); STAGE(SBO(1, 1), Bp, bcol + 128, 1);
  WAIT_V(6); BAR;
  for (int t = 0; t < nt - 2; t += 2) {
    LDB(B0, 0, 0); SCHED; LDA(At, 0, 0); STAGE(SAO(1, 1), Ap, brow + 128, t + 1);
    WAIT_L(8); BAR; WAIT_L(0); MMA(0, 0, At, B0); BAR; SCHED;
    LDB(B1, 0, 1); STAGE(SBO(0, 0), Bp, bcol, t + 2);
    BAR; WAIT_L(0); MMA(0, 1, At, B1); BAR;
    LDA(At, 0, 1); STAGE(SAO(0, 0), Ap, brow, t + 2);
    BAR; WAIT_L(0); MMA(1, 0, At, B0); BAR; SCHED;
    STAGE(SBO(0, 1), Bp, bcol + 128, t + 2);
    WAIT_V(6); BAR; MMA(1, 1, At, B1); BAR;
    LDB(B0, 1, 0); SCHED; LDA(At, 1, 0); STAGE(SAO(0, 1), Ap, brow + 128, t + 2);
    WAIT_L(8); BAR; WAIT_L(0); MMA(0, 0, At, B0); BAR; SCHED;
    LDB(B1, 1, 1); STAGE(SBO(1, 0), Bp, bcol, t + 3);
    BAR; WAIT_L(0); MMA(0, 1, At, B1); BAR;
    LDA(At, 1, 1); STAGE(SAO(1, 0), Ap, brow, t + 3);
    BAR; WAIT_L(0); MMA(1, 0, At, B0); BAR; SCHED;
    STAGE(SBO(1, 1), Bp, bcol + 128, t + 3);
    WAIT_V(6); BAR; MMA(1, 1, At, B1); BAR;
  }
  { LDB(B0, 0, 0); LDA(At, 0, 0); STAGE(SAO(1, 1), Ap, brow + 128, nt - 1);
    BAR; WAIT_L(0); MMA(0, 0, At, B0); BAR;
    LDB(B1, 0, 1); BAR; WAIT_L(0); MMA(0, 1, At, B1); BAR;
    LDA(At, 0, 1); WAIT_V(4); BAR; WAIT_L(0); MMA(1, 0, At, B0); MMA(1, 1, At, B1); BAR; }
  { LDB(B0, 1, 0); LDA(At, 1, 0); WAIT_V(2); BAR; WAIT_L(0); MMA(0, 0, At, B0); BAR;
    LDB(B1, 1, 1); WAIT_V(0); BAR; WAIT_L(0); MMA(0, 1, At, B1); BAR;
    LDA(At, 1, 1); BAR; WAIT_L(0); MMA(1, 0, At, B0); MMA(1, 1, At, B1); BAR; }
  if (wr == 0) BAR;
  }
  { int l2 = lane; asm volatile("" : "+v"(l2));
    gemm_epilogue<MODE>(P, acc, pm, pn_epi, wr, wc, l2 & 15, l2 >> 4); }
#undef SAO
#undef SBO
#undef STAGE
#undef LDA
#undef LDB
#undef MMA
}


template <int MODE>
__device__ __forceinline__ void gemm_stream(const Params& P, const bf16_t* __restrict__ A, const bf16_t* __restrict__ Bt, const int K, const int pn_lo, const int npn, const int pnb_lo) {
  LAS unsigned char* lds = (LAS unsigned char*)smem;
  const int G = GRIDX, u0 = vcu_id_(GRIDX), nunits = (NTOK / 256) * npn;
  if (u0 >= nunits) return;
  const int nmine = (nunits - u0 + G - 1) / G;
  const int tid = otid(), wid = __builtin_amdgcn_readfirstlane(tid >> 6), lane = tid & 63, wr = wid >> 2, wc = wid & 3, fr = lane & 15, fq = lane >> 4;
  const int nt = K / BK;
  unsigned goff[2];
  { int R, C; stage_rc(tid * 16, R, C); goff[0] = (unsigned)(R * K + C) * 2u; goff[1] = goff[0] + (unsigned)(64 * K) * 2u; }
  const size_t half = (size_t)128 * K;
#define SAO(b, h) (((b) * 2 + (h)) * HTB)
#define SBO(b, h) ((4 + (b) * 2 + (h)) * HTB)
#define STAGE(PO, BASE, kt) do { const char* _g = (const char*)((BASE) + (size_t)(kt) * BK); \
    _Pragma("unroll") for (int _i = 0; _i < 2; ++_i) \
      __builtin_amdgcn_global_load_lds((const unsigned*)(_g + goff[_i]), (LAS unsigned*)(lds + (PO) + wid * 1024 + _i * 8192), 16, 0, 0); } while (0)
#define LDA(dst, b, h) _Pragma("unroll") for (int m = 0; m < 4; ++m) _Pragma("unroll") for (int k = 0; k < 2; ++k) \
    dst[m][k] = *(const LAS bf16x8*)(lds + SAO(b, h) + lds_byte(wr * 64 + m * 16 + fr, k * 32 + fq * 8))
#define LDB(dst, b, h) _Pragma("unroll") for (int n = 0; n < 2; ++n) _Pragma("unroll") for (int k = 0; k < 2; ++k) \
    dst[n][k] = *(const LAS bf16x8*)(lds + SBO(b, h) + lds_byte(wc * 32 + n * 16 + fr, k * 32 + fq * 8))
#define MMA(ai, bj, AT, BT) do { __builtin_amdgcn_s_setprio(1); \
    _Pragma("unroll") for (int m = 0; m < 4; ++m) _Pragma("unroll") for (int n = 0; n < 2; ++n) _Pragma("unroll") for (int k = 0; k < 2; ++k) \
      acc[ai][bj][m][n] = __builtin_amdgcn_mfma_f32_16x16x32_bf16(BT[n][k], AT[m][k], acc[ai][bj][m][n], 0, 0, 0); \
    __builtin_amdgcn_s_setprio(0); } while (0)
  f32x4 acc[2][2][4][2] = {};
  bf16x8 At[4][2], B0[2][2], B1[2][2];
  int uiN = 0, ktN = 0, pmP, plP, ktP;
  const bf16_t *aP, *bP, *aN, *bN;
  { const int u = u0, pm = u / npn, pl = u - pm * npn; pmP = pm; plP = pl; ktP = 0;
    aP = A + (size_t)pm * 256 * K; bP = Bt + (size_t)(pnb_lo + pl) * 256 * K; aN = aP; bN = bP; }
  int pmN = pmP, plN = plP;
#define ADVANCE_N() do { ktN += 2; if (ktN == nt) { if (uiN + 1 < nmine) { ++uiN; ktN = 0; const int u = u0 + uiN * G; pmN = u / npn; plN = u - pmN * npn; \
      aN = A + (size_t)pmN * 256 * K; bN = Bt + (size_t)(pnb_lo + plN) * 256 * K; } else { ktN = nt - 2; } } } while (0)
  __syncthreads();
  STAGE(SBO(0, 0), bP, 0); STAGE(SAO(0, 0), aP, 0);
  STAGE(SBO(0, 1), bP + half, 0); STAGE(SAO(0, 1), aP + half, 0);
  if (wr == 1) BAR;
  WAIT_V(4); BAR;
  STAGE(SBO(1, 0), bP, 1); STAGE(SAO(1, 0), aP, 1); STAGE(SBO(1, 1), bP + half, 1);
  WAIT_V(6); BAR;
  ADVANCE_N();
  const int npairs = nmine * (nt >> 1);
  for (int q = 0; q < npairs; ++q) {
    LDB(B0, 0, 0); SCHED; LDA(At, 0, 0); STAGE(SAO(1, 1), aP + half, ktP + 1);
    WAIT_L(8); BAR; WAIT_L(0); MMA(0, 0, At, B0); BAR; SCHED;
    LDB(B1, 0, 1); STAGE(SBO(0, 0), bN, ktN);
    BAR; WAIT_L(0); MMA(0, 1, At, B1); BAR;
    LDA(At, 0, 1); STAGE(SAO(0, 0), aN, ktN);
    BAR; WAIT_L(0); MMA(1, 0, At, B0); BAR; SCHED;
    STAGE(SBO(0, 1), bN + half, ktN);
    WAIT_V(6); BAR; MMA(1, 1, At, B1); BAR;
    LDB(B0, 1, 0); SCHED; LDA(At, 1, 0); STAGE(SAO(0, 1), aN + half, ktN);
    WAIT_L(8); BAR; WAIT_L(0); MMA(0, 0, At, B0); BAR; SCHED;
    LDB(B1, 1, 1); STAGE(SBO(1, 0), bN, ktN + 1);
    BAR; WAIT_L(0); MMA(0, 1, At, B1); BAR;
    LDA(At, 1, 1); STAGE(SAO(1, 0), aN, ktN + 1);
    BAR; WAIT_L(0); MMA(1, 0, At, B0); BAR; SCHED;
    STAGE(SBO(1, 1), bN + half, ktN + 1);
    WAIT_V(6); BAR; MMA(1, 1, At, B1); BAR;
    if (ktP + 2 == nt) {
      { int l2 = lane; asm volatile("" : "+v"(l2));
        gemm_epilogue<MODE>(P, acc, pmP, pn_lo + plP, wr, wc, l2 & 15, l2 >> 4); }
#pragma unroll
      for (int ai = 0; ai < 2; ++ai)
#pragma unroll
        for (int bj = 0; bj < 2; ++bj)
#pragma unroll
          for (int m = 0; m < 4; ++m)
#pragma unroll
            for (int n = 0; n < 2; ++n) acc[ai][bj][m][n] = (f32x4){0.f, 0.f, 0.f, 0.f};
    }
    aP = aN; bP = bN; ktP = ktN; pmP = pmN; plP = plN;
    ADVANCE_N();
  }
  WAIT_V(0);
  if (wr == 0) BAR;
  __syncthreads();
#undef SAO
#undef SBO
#undef STAGE
#undef LDA
#undef LDB
#undef MMA
#undef ADVANCE_N
}

#define KSWZ(row, colB) ((row) * 256 + ((colB) ^ (((row) & 7) << 4)))
#define SBAR() __builtin_amdgcn_sched_barrier(0)
constexpr int AT_NBUF = 3, AT_V = 64 * 64 * 2, AT_K = 64 * 256, AT_KOFF = AT_NBUF * AT_V, AT_WSOFF = AT_NBUF * (AT_V + AT_K);
__device__ __forceinline__ int crow(int r, int hi) { return (r & 3) + 8 * (r >> 2) + 4 * hi; }
__device__ __forceinline__ int v_st(int k, int c) { const int kk = (k & ~0xC) | ((k & 4) << 1) | ((k & 8) >> 1); return ((kk >> 3) * 2 + (c >> 5)) * 512 + ((kk & 7) * 32 + (c & 31)) * 2; }
__device__ __forceinline__ int v_rd_base(int lane) { return ((lane & 3) << 3) | (((lane >> 2) & 3) << 6) | (((lane >> 4) & 1) << 5) | (((lane >> 5) & 1) << 8); }
constexpr int v_rd_off(int d0, int ks, int half) { return d0 * 512 + ks * 2048 + half * 1024; }
template <int OFF> __device__ __forceinline__ s16x4 tr_read(int vb) {
  s16x4 r; asm volatile("ds_read_b64_tr_b16 %0, %1 offset:%2" : "=&v"(r) : "v"(vb), "i"(OFF) : "memory"); return r;
}
template <int D0> __device__ __forceinline__ void pv_one(f32x16& od, int vb, bf16x8 pa0, bf16x8 pa1, bf16x8 pa2, bf16x8 pa3) {
  const s16x4 l0 = tr_read<v_rd_off(D0, 0, 0)>(vb), h0 = tr_read<v_rd_off(D0, 0, 1)>(vb), l1 = tr_read<v_rd_off(D0, 1, 0)>(vb), h1 = tr_read<v_rd_off(D0, 1, 1)>(vb);
  const s16x4 l2 = tr_read<v_rd_off(D0, 2, 0)>(vb), h2 = tr_read<v_rd_off(D0, 2, 1)>(vb), l3 = tr_read<v_rd_off(D0, 3, 0)>(vb), h3 = tr_read<v_rd_off(D0, 3, 1)>(vb);
  asm volatile("s_waitcnt lgkmcnt(0)" ::: "memory"); SBAR();
#define PK(L, H) (bf16x8){L[0], L[1], L[2], L[3], H[0], H[1], H[2], H[3]}
  od = __builtin_amdgcn_mfma_f32_32x32x16_bf16(pa0, PK(l0, h0), od, 0, 0, 0);
  od = __builtin_amdgcn_mfma_f32_32x32x16_bf16(pa1, PK(l1, h1), od, 0, 0, 0);
  od = __builtin_amdgcn_mfma_f32_32x32x16_bf16(pa2, PK(l2, h2), od, 0, 0, 0);
  od = __builtin_amdgcn_mfma_f32_32x32x16_bf16(pa3, PK(l3, h3), od, 0, 0, 0);
#undef PK
}
__device__ __forceinline__ void partialSM(f32x16& p0, f32x16& p1, float& m_reg, float& mn, float& alpha, const float C, const float thr_raw) {
  float pmax = p0[0];
#pragma unroll
  for (int r = 1; r < 16; ++r) pmax = fmaxf(pmax, p0[r]);
#pragma unroll
  for (int r = 0; r < 16; ++r) pmax = fmaxf(pmax, p1[r]);
  { auto rr = __builtin_amdgcn_permlane32_swap(__float_as_uint(pmax), __float_as_uint(pmax), false, false);
    pmax = fmaxf(__uint_as_float(rr[0]), __uint_as_float(rr[1])); }
  if (__builtin_expect(__all(pmax - m_reg <= thr_raw), 1)) { mn = m_reg; alpha = 1.f; }
  else { mn = fmaxf(m_reg, pmax); alpha = __builtin_amdgcn_exp2f((m_reg - mn) * C); m_reg = mn; }
  const float mnC = -mn * C;
#pragma unroll
  for (int r = 0; r < 16; ++r) p0[r] = fmaf(p0[r], C, mnC);
#pragma unroll
  for (int r = 0; r < 16; ++r) p1[r] = fmaf(p1[r], C, mnC);
#pragma unroll
  for (int r = 0; r < 16; ++r) p0[r] = __builtin_amdgcn_exp2f(p0[r]);
}
__device__ __forceinline__ void finishSM(f32x16& p0, f32x16& p1, float alpha, float& l_reg, bf16x8& pa0, bf16x8& pa1, bf16x8& pa2, bf16x8& pa3) {
#pragma unroll
  for (int r = 0; r < 16; ++r) p1[r] = __builtin_amdgcn_exp2f(p1[r]);
  float ps = 0;
#pragma unroll
  for (int r = 0; r < 16; ++r) ps += p0[r];
#pragma unroll
  for (int r = 0; r < 16; ++r) ps += p1[r];
  { auto rr = __builtin_amdgcn_permlane32_swap(__float_as_uint(ps), __float_as_uint(ps), false, false);
    ps = __uint_as_float(rr[0]) + __uint_as_float(rr[1]); }
  l_reg = l_reg * alpha + ps;
#define PK4(Pv, BASE, OUT) do { unsigned a0 = cvtpk(Pv[BASE + 0], Pv[BASE + 1]), a1 = cvtpk(Pv[BASE + 2], Pv[BASE + 3]);   \
    unsigned b0 = cvtpk(Pv[BASE + 4], Pv[BASE + 5]), b1 = cvtpk(Pv[BASE + 6], Pv[BASE + 7]);                              \
    auto r0 = __builtin_amdgcn_permlane32_swap(a0, b0, false, false); auto r1 = __builtin_amdgcn_permlane32_swap(a1, b1, false, false); \
    u32x4 w = {r0[0], r1[0], r0[1], r1[1]}; OUT = *reinterpret_cast<bf16x8*>(&w); } while (0)
  PK4(p0, 0, pa0); PK4(p0, 8, pa1); PK4(p1, 0, pa2); PK4(p1, 8, pa3);
#undef PK4
}

template <int NQ, bool MASK>
__device__ __forceinline__ void attn_body(const bf16_t* __restrict__ Qb, const long ldq, const bf16_t* __restrict__ Kh, const long ldk,
                                          const bf16_t* __restrict__ Vh, const long ldv, const int NT, const float C, const float thr_raw, const int mdelta,
                                          f32x16 (&o)[2], float& m_reg, float& l_reg) {
  LAS unsigned char* lds = (LAS unsigned char*)smem;
  const int tid = otid(), wid = __builtin_amdgcn_readfirstlane(tid >> 6), lane = tid & 63, r32 = lane & 31, hi = lane >> 5;
  LAS float* wsl = (LAS float*)(lds + AT_WSOFF) + wid * 64; LAS float* al_l = wsl + 32;
  m_reg = MASK ? -30000.f : -1e30f; l_reg = 0.f;
  o[0] = f32x16{}; o[1] = f32x16{};
  bf16x8 qr[NQ];
  const bf16_t* Qw = Qb + (long)(wid * 32 + r32) * ldq + hi * 8;
#pragma unroll
  for (int d0 = 0; d0 < NQ; ++d0) qr[d0] = *(const bf16x8*)(Qw + d0 * 16);
  int kr0, kc0, kr1 = 0, kc1 = 0;
  if constexpr (NQ == 6) { kr0 = tid / 12; kc0 = (tid % 12) * 8; const int c1 = 512 + (tid & 255); kr1 = c1 / 12; kc1 = (c1 % 12) * 8; }
  else { kr0 = tid >> 3; kc0 = (tid & 7) * 8; }
  const int vr = tid >> 3, vc = (tid & 7) * 8;
  const int kst0 = KSWZ(kr0, kc0 * 2), kst1 = KSWZ(kr1, kc1 * 2), vst = v_st(vr, vc);
  const int vb0 = (int)(unsigned)(uintptr_t)lds + v_rd_base(lane);
  struct { bf16x8 v, k0, k1; } sr_[2];
#define SLOAD(i, kk0) do { sr_[i].v = *(const bf16x8*)(Vh + (long)((kk0) + vr) * ldv + vc); sr_[i].k0 = *(const bf16x8*)(Kh + (long)((kk0) + kr0) * ldk + kc0); \
    if (NQ == 6 && wid < 4) sr_[i].k1 = *(const bf16x8*)(Kh + (long)((kk0) + kr1) * ldk + kc1); } while (0)
#define SWRITE(b, i) do { *(LAS bf16x8*)(lds + (b) * AT_V + vst) = sr_[i].v; *(LAS bf16x8*)(lds + AT_KOFF + (b) * AT_K + kst0) = sr_[i].k0; \
    if (NQ == 6 && wid < 4) *(LAS bf16x8*)(lds + AT_KOFF + (b) * AT_K + kst1) = sr_[i].k1; } while (0)
#define SWAIT() do { if constexpr (NQ == 6) asm volatile("s_waitcnt vmcnt(3)" ::: "memory"); else asm volatile("s_waitcnt vmcnt(2)" ::: "memory"); } while (0)
#define RESC(a) do { if (__any((a) < 1.f)) { if (hi == 0) al_l[r32] = (a); asm volatile("s_waitcnt lgkmcnt(0)" ::: "memory"); \
    _Pragma("unroll") for (int d = 0; d < 2; ++d) _Pragma("unroll") for (int r = 0; r < 16; ++r) o[d][r] *= al_l[crow(r, hi)]; } } while (0)
#define QKT(P0, P1, b, tile) do { P0 = f32x16{}; P1 = f32x16{}; \
    _Pragma("unroll") for (int d0 = 0; d0 < NQ; ++d0) { const int cb = (d0 * 16 + hi * 8) * 2; \
      const bf16x8 b0 = *(const LAS bf16x8*)(lds + AT_KOFF + (b) * AT_K + KSWZ(r32, cb)); \
      const bf16x8 b1 = *(const LAS bf16x8*)(lds + AT_KOFF + (b) * AT_K + KSWZ(32 + r32, cb)); \
      P0 = __builtin_amdgcn_mfma_f32_32x32x16_bf16(b0, qr[d0], P0, 0, 0, 0); \
      P1 = __builtin_amdgcn_mfma_f32_32x32x16_bf16(b1, qr[d0], P1, 0, 0, 0); } \
    if constexpr (MASK) { const int dl = mdelta + (tile) * 64 - (wid * 32 + r32) + 4 * hi; \
      _Pragma("unroll") for (int r = 0; r < 16; ++r) { const int dd = dl + (r & 3) + 8 * (r >> 2); \
        if ((unsigned)(dd + 64) > 128u) P0[r] = -1e30f; if ((unsigned)(dd + 96) > 128u) P1[r] = -1e30f; } } } while (0)
#define PV(b) do { pv_one<0>(o[0], vb0 + (b) * AT_V, pa0, pa1, pa2, pa3); pv_one<1>(o[1], vb0 + (b) * AT_V, pa0, pa1, pa2, pa3); } while (0)
  f32x16 pA0, pA1, pB0, pB1; float mnA = 0.f, mnB = 0.f, alA = 1.f, alB = 1.f; bf16x8 pa0, pa1, pa2, pa3;
  int jlo = 0, jhi = NT - 1;
  if constexpr (MASK) {
    const int a = 32 * wid - 127 - mdelta + 63, b = 32 * wid + 95 - mdelta;
    jlo = a >= 0 ? a / 64 : -((-a + 63) / 64); jhi = b >= 0 ? b / 64 : -((-b + 63) / 64);
    jlo = jlo < 0 ? 0 : jlo; jhi = jhi > NT - 1 ? NT - 1 : jhi;
  }
#define NEED(j) (!MASK || ((j) >= jlo && (j) <= jhi))
  SLOAD(0, 0); asm volatile("s_waitcnt vmcnt(0)" ::: "memory"); SWRITE(0, 0); __syncthreads();
  if (NEED(0)) { QKT(pA0, pA1, 0, 0); partialSM(pA0, pA1, m_reg, mnA, alA, C, thr_raw); }
  SLOAD(1, 64); if (2 < NT) SLOAD(0, 128);
  SWAIT(); SWRITE(1, 1); __syncthreads();
#define STEP(PC0, PC1, ALC, MNC, PP0, PP1, ALP, BC, BP, BN, T) do { \
    SBAR(); QKT(PC0, PC1, BC, T); \
    finishSM(PP0, PP1, ALP, l_reg, pa0, pa1, pa2, pa3); __builtin_amdgcn_iglp_opt(2); SBAR();     \
    if ((T) + 2 < NT) { if ((T) & 1) SLOAD(1, ((T) + 2) * 64); else SLOAD(0, ((T) + 2) * 64); } SBAR(); \
    PV(BP); partialSM(PC0, PC1, m_reg, MNC, ALC, C, thr_raw); __builtin_amdgcn_iglp_opt(2); \
    SWAIT(); if ((T) & 1) SWRITE(BN, 0); else SWRITE(BN, 1); \
    RESC(ALC); __syncthreads(); } while (0)
  for (int j = 1; j + 1 < NT; j += 6) {
    STEP(pB0, pB1, alB, mnB, pA0, pA1, alA, 1, 0, 2, j);
    STEP(pA0, pA1, alA, mnA, pB0, pB1, alB, 2, 1, 0, j + 1);
    STEP(pB0, pB1, alB, mnB, pA0, pA1, alA, 0, 2, 1, j + 2);
    STEP(pA0, pA1, alA, mnA, pB0, pB1, alB, 1, 0, 2, j + 3);
    STEP(pB0, pB1, alB, mnB, pA0, pA1, alA, 2, 1, 0, j + 4);
    STEP(pA0, pA1, alA, mnA, pB0, pB1, alB, 0, 2, 1, j + 5);
  }
  SBAR(); QKT(pB0, pB1, 1, NT - 1);
  finishSM(pA0, pA1, alA, l_reg, pa0, pa1, pa2, pa3); SBAR();
  PV(0); partialSM(pB0, pB1, m_reg, mnB, alB, C, thr_raw);
  RESC(alB);
  finishSM(pB0, pB1, alB, l_reg, pa0, pa1, pa2, pa3); SBAR();
  PV(1);
#undef STEP
#undef NEED
  if (hi == 0) wsl[r32] = l_reg;
  asm volatile("s_waitcnt lgkmcnt(0)" ::: "memory");
#pragma unroll
  for (int r = 0; r < 16; ++r) { const float rl = __builtin_amdgcn_rcpf(wsl[crow(r, hi)]); o[0][r] *= rl; o[1][r] *= rl; }
#undef SLOAD
#undef SWRITE
#undef SWAIT
#undef RESC
#undef QKT
#undef PV
}

constexpr int DL_V = 0, DL_K = 6 * 8192, DL_WS = 12 * 8192, DL_OUT = 12 * 8192 + 2048;
#define KSW2(row, colB) ((row) * 128 + ((colB) ^ ((((row) >> 1) & 7) << 4)))
__device__ __forceinline__ void dil_compute(const bf16x8 (&qr)[4], const int mdelta, f32x16 (&o)[2], float& m_reg, float& l_reg) {
  LAS unsigned char* lds = (LAS unsigned char*)smem;
  const int tid = otid(), wid = __builtin_amdgcn_readfirstlane(tid >> 6), lane = tid & 63, r32 = lane & 31, hi = lane >> 5;
  LAS float* wsl = (LAS float*)(lds + DL_WS) + wid * 64; LAS float* al_l = wsl + 32;
  m_reg = -30000.f; l_reg = 0.f; o[0] = f32x16{}; o[1] = f32x16{};
  int jlo, jhi;
  { const int a = 32 * wid - 127 - mdelta + 63, b = 32 * wid + 95 - mdelta;
    jlo = a >= 0 ? a / 64 : -((-a + 63) / 64); jhi = b >= 0 ? b / 64 : -((-b + 63) / 64);
    jlo = jlo < 0 ? 0 : jlo; jhi = jhi > 5 ? 5 : jhi; }
  const int vb0 = (int)(unsigned)(uintptr_t)lds + DL_V + v_rd_base(lane);
#pragma unroll 1
  for (int j = jlo; j <= jhi; ++j) {
    f32x16 p0 = f32x16{}, p1 = f32x16{};
    LAS unsigned char* kt = lds + DL_K + j * 8192;
#pragma unroll
    for (int d0 = 0; d0 < 4; ++d0) { const int cb = (d0 * 16 + hi * 8) * 2;
      const bf16x8 b0 = *(const LAS bf16x8*)(kt + KSW2(r32, cb)), b1 = *(const LAS bf16x8*)(kt + KSW2(32 + r32, cb));
      p0 = __builtin_amdgcn_mfma_f32_32x32x16_bf16(b0, qr[d0], p0, 0, 0, 0);
      p1 = __builtin_amdgcn_mfma_f32_32x32x16_bf16(b1, qr[d0], p1, 0, 0, 0); }
    { const int dl = mdelta + j * 64 - (wid * 32 + r32) + 4 * hi;
#pragma unroll
      for (int r = 0; r < 16; ++r) { const int dd = dl + (r & 3) + 8 * (r >> 2);
        if ((unsigned)(dd + 64) > 128u) p0[r] = -1e30f; if ((unsigned)(dd + 96) > 128u) p1[r] = -1e30f; } }
    float mn, alpha; bf16x8 pa0, pa1, pa2, pa3;
    partialSM(p0, p1, m_reg, mn, alpha, LOG2E, 8.f);
    if (__any(alpha < 1.f)) { if (hi == 0) al_l[r32] = alpha; asm volatile("s_waitcnt lgkmcnt(0)" ::: "memory");
#pragma unroll
      for (int d = 0; d < 2; ++d)
#pragma unroll
        for (int r = 0; r < 16; ++r) o[d][r] *= al_l[crow(r, hi)]; }
    finishSM(p0, p1, alpha, l_reg, pa0, pa1, pa2, pa3);
    const int vb = vb0 + j * 8192;
    pv_one<0>(o[0], vb, pa0, pa1, pa2, pa3); pv_one<1>(o[1], vb, pa0, pa1, pa2, pa3);
  }
  if (hi == 0) wsl[r32] = l_reg;
  asm volatile("s_waitcnt lgkmcnt(0)" ::: "memory");
#pragma unroll
  for (int r = 0; r < 16; ++r) { const float rl = __builtin_amdgcn_rcpf(wsl[crow(r, hi)]); o[0][r] *= rl; o[1][r] *= rl; }
}

__device__ __forceinline__ int perm_in(int p) { const int g = p >> 5, n = (p >> 4) & 1, fq = (p >> 2) & 3, j = p & 3; return (g >> 1) * 64 + (g & 1) * 16 + n * 32 + fq * 4 + j; }
__device__ __forceinline__ void prep_store(bf16_t* dst, const float* W, const int ldw, const int sc, const int k0, const int kvalid, const float* g) {
  float v[8];
#pragma unroll
  for (int e = 0; e < 8; ++e) { const int k = k0 + e; float t = 0.f; if (sc >= 0 && k < kvalid) { t = W[(size_t)k * ldw + sc]; if (g) t *= g[k]; } v[e] = t; }
  u32x4 w = {cvtpk(v[0], v[1]), cvtpk(v[2], v[3]), cvtpk(v[4], v[5]), cvtpk(v[6], v[7])};
  *(u32x4*)dst = w;
}
__device__ void phase_prep(const Params& P) {
  unsigned char* ws = P.ws;
  const long gtid = (long)blockIdx.x * NTHREADS + otid(), gsz = (long)GRIDX * NTHREADS;
  for (long it = gtid; it < 8192L * 128; it += gsz) {
    const int n = (int)(it % 8192), k8 = (int)(it / 8192);
    const int t = n >> 8, l = perm_in(n & 255);
    int sc;
    if (t == 0) sc = l;
    else if (t == 1) sc = (l < 128) ? 256 + l : (l < 160 ? 384 + (l - 128) : -1);
    else if (t < 4) sc = 416 + (t - 2) * 256 + l;
    else if (t < 8) sc = 6048 + (t - 4) * 256 + l;
    else if (t < 12) sc = 7072 + (t - 8) * 256 + l;
    else if (t < 18) sc = 928 + (t - 12) * 256 + l;
    else if (t < 24) sc = 2464 + (t - 18) * 256 + l;
    else if (t < 30) sc = 4000 + (t - 24) * 256 + l;
    else sc = 5536 + (t - 30) * 256 + l;
    prep_store((bf16_t*)(ws + WS_WIN) + (size_t)n * 1024 + k8 * 8, P.w_in, INW, sc, k8 * 8, 1024, nullptr);
  }
  for (long it = gtid; it < 1024L * 32; it += gsz) {
    const int n = (int)(it % 1024), k8 = (int)(it / 1024);
    const int t = n >> 8, p = n & 255, gi = p >> 5, nn = (p >> 4) & 1, fq = (p >> 2) & 3, j = p & 3;
    const int head = 2 * t + (gi >> 2), sub = gi & 3;
    int sc;
    if (sub < 2) sc = head * 96 + sub * 32 + nn * 16 + fq * 4 + j;
    else if (sub == 2) sc = head * 96 + 64 + nn * 16 + fq * 4 + j;
    else sc = -1;
    prep_store((bf16_t*)(ws + WS_WUQ) + (size_t)n * 256 + k8 * 8, P.w_uq, 768, sc, k8 * 8, 256, P.gq);
  }
  for (long it = gtid; it < 1024L * 32; it += gsz) {
    const int n = (int)(it % 1024), k8 = (int)(it / 1024);
    prep_store((bf16_t*)(ws + WS_WUKV) + (size_t)n * 256 + k8 * 8, P.w_ukv, 1024, n, k8 * 8, 128, P.gkv);
  }
  for (long it = gtid; it < 1024L * 64; it += gsz) {
    const int n = (int)(it % 1024), k8 = (int)(it / 1024);
    prep_store((bf16_t*)(ws + WS_WOM) + (size_t)n * 512 + k8 * 8, P.w_om, 1024, n, k8 * 8, 512, nullptr);
    prep_store((bf16_t*)(ws + WS_WOD) + (size_t)n * 512 + k8 * 8, P.w_od, 1024, n, k8 * 8, 512, nullptr);
  }
  for (long it = gtid; it < 1024L * 128; it += gsz) {
    const int n = (int)(it % 1024), k8 = (int)(it / 1024);
    prep_store((bf16_t*)(ws + WS_WOUT) + (size_t)n * 1024 + k8 * 8, P.w_out, 1024, n, k8 * 8, 1024, nullptr);
  }
  for (long it = gtid; it < (long)NTOK * 32; it += gsz) {
    const int tok = (int)(it >> 5), i = (int)(it & 31);
    const double ang = (double)P.pos[tok] * (double)P.inv_freq[i];
    double rev = ang * 0.15915494309189535; rev -= floor(rev);
    const float rf = (float)rev;
    ((float*)(ws + WS_COS))[it] = __builtin_amdgcn_cosf(rf);
    ((float*)(ws + WS_SIN))[it] = __builtin_amdgcn_sinf(rf);
  }
  {
    const int lane = otid() & 63; const long wv = gtid >> 6, nwv = gsz >> 6;
    bf16_t* H = (bf16_t*)P.out;
    f32x4 g4[4];
#pragma unroll
    for (int c = 0; c < 4; ++c) g4[c] = *(const f32x4*)(P.attn_g + c * 256 + lane * 4);
    for (long row = wv; row < NTOK; row += nwv) {
      const float* xr = P.x + row * DM; f32x4 v[4]; float ss = 0.f;
#pragma unroll
      for (int c = 0; c < 4; ++c) { v[c] = __builtin_nontemporal_load((const f32x4*)(xr + c * 256 + lane * 4)); ss += v[c][0] * v[c][0] + v[c][1] * v[c][1] + v[c][2] * v[c][2] + v[c][3] * v[c][3]; }
      ss = wave_sum(ss);
      const float rs = rsqrtf(ss * (1.f / DM) + RMS_EPS);
#pragma unroll
      for (int c = 0; c < 4; ++c) { f32x4 t = v[c] * rs * g4[c]; st4bf(H + row * DM + c * 256 + lane * 4, t); }
    }
  }
}

constexpr int STAGGER_TICKS = 0;
template <int MODE>
__device__ void phase_gemm(const Params& P, const bf16_t* A, const bf16_t* Bt, const int K, const int pn_lo, const int npn, const int pnb_lo) {
  const int G = GRIDX, v = vcu_id_(GRIDX), nunits = (NTOK / 256) * npn;
  const bool xl = (G == 256) && ((npn & 3) == 0);
  if constexpr (MODE == M_IN) {
    const int ticks = (v & 7) * STAGGER_TICKS;
    if (ticks > 0) { const unsigned long long t0 = __builtin_amdgcn_s_memrealtime(); while (__builtin_amdgcn_s_memrealtime() - t0 < (unsigned long long)ticks) __builtin_amdgcn_s_sleep(8); }
  }
  const int nr = xl ? (npn >> 1) : (v < nunits ? (nunits - v + G - 1) / G : 0);
#pragma unroll 1
  for (int i = 0; i < nr; ++i) {
    int pm, pl;
    if (xl) { pm = 16 * (v >> 5) + 8 * (i & 1) + (v & 7); pl = 4 * (i >> 1) + ((v & 31) >> 3); }
    else { const int u = v + i * G; pm = u / npn; pl = u - pm * npn; }
    gemm_tile<MODE>(P, A, Bt, K, pm, pnb_lo + pl, pn_lo + pl);
  }
  __syncthreads();
}

struct DilUnit { const bf16_t* Qb; const bf16_t* Kb; const bf16_t* Vb; long ld; int mdelta, b, p0, dil, rho, gh; };
__device__ __forceinline__ DilUnit dil_decode(const Params& P, const int u) {
  const bf16_t* QD = (const bf16_t*)(P.ws + WS_QD); const bf16_t* KD = (const bf16_t*)(P.ws + WS_KD); const bf16_t* VD = (const bf16_t*)(P.ws + WS_VD);
  const int g = u >> 10, rem = u & 1023, b = rem >> 8, h8 = (rem >> 5) & 7, xx = rem & 31;
  const int dil = (g == 0) ? 1 : (g == 1 ? 4 : 16), L = SEQ / dil;
  const int rho = xx % dil, blk = xx / dil, gh = g * 8 + h8, p0 = blk * 256;
  int t0 = p0 / 64 - 1; t0 = t0 < 0 ? 0 : t0; if (t0 > L / 64 - 6) t0 = L / 64 - 6;
  const int k0 = t0 * 64;
  DilUnit U; U.ld = (long)dil * 1536; U.mdelta = k0 - p0; U.b = b; U.p0 = p0; U.dil = dil; U.rho = rho; U.gh = gh;
  U.Qb = QD + ((long)b * SEQ + (long)p0 * dil + rho) * 1536 + gh * 64;
  U.Kb = KD + ((long)b * SEQ + (long)k0 * dil + rho) * 1536 + gh * 64;
  U.Vb = VD + ((long)b * SEQ + (long)k0 * dil + rho) * 1536 + gh * 64;
  return U;
}
__device__ void phase_dilated(const Params& P) {
  unsigned char* ws = P.ws;
  LAS unsigned char* lds = (LAS unsigned char*)smem;
  bf16_t* OG = (bf16_t*)(ws + WS_OG); float* LSE = (float*)(ws + WS_LSE);
  const int tid = otid(), wid = __builtin_amdgcn_readfirstlane(tid >> 6), lane = tid & 63, r32 = lane & 31, hi = lane >> 5;
  const int sr = tid >> 3, sc = (tid & 7) * 8, kst = KSW2(sr, sc * 2), vst = v_st(sr, sc);
  const int G = GRIDX;
  int u = vcu_id_(G);
  if (u >= 3072) return;
  DilUnit U = dil_decode(P, u);
  bf16x8 kk[6], vv[6], qn[4];
#define DIL_LOADS(UU) do { _Pragma("unroll") for (int t = 0; t < 6; ++t) { kk[t] = *(const bf16x8*)((UU).Kb + (long)(t * 64 + sr) * (UU).ld + sc); vv[t] = *(const bf16x8*)((UU).Vb + (long)(t * 64 + sr) * (UU).ld + sc); } \
    _Pragma("unroll") for (int d0 = 0; d0 < 4; ++d0) qn[d0] = *(const bf16x8*)((UU).Qb + (long)(wid * 32 + r32) * (UU).ld + hi * 8 + d0 * 16); } while (0)
  DIL_LOADS(U);
#pragma unroll 1
  for (; u < 3072; u += G) {
    const DilUnit C = U;
    bf16x8 qr[4];
#pragma unroll
    for (int t = 0; t < 6; ++t) { *(LAS bf16x8*)(lds + DL_K + t * 8192 + kst) = kk[t]; *(LAS bf16x8*)(lds + DL_V + t * 8192 + vst) = vv[t]; }
#pragma unroll
    for (int d0 = 0; d0 < 4; ++d0) qr[d0] = qn[d0];
    __syncthreads();
    if (u + G < 3072) { U = dil_decode(P, u + G); DIL_LOADS(U); }
    f32x16 o[2]; float m_reg, l_reg;
    dil_compute(qr, C.mdelta, o, m_reg, l_reg);
    {
      LAS unsigned char* ob = lds + DL_OUT + wid * (32 * 128);
#pragma unroll
      for (int r = 0; r < 16; ++r)
#pragma unroll
        for (int d0 = 0; d0 < 2; ++d0) *(LAS unsigned short*)(ob + crow(r, hi) * 128 + (d0 * 32 + r32) * 2) = (unsigned short)(cvtpk(o[d0][r], 0.f) & 0xffffu);
#pragma unroll
      for (int i = 0; i < 4; ++i) { const int row = (lane >> 3) + 8 * i, ch = lane & 7;
        const u32x4 w = *(const LAS u32x4*)(ob + row * 128 + ch * 16);
        const long tok = (long)C.b * SEQ + (long)(C.p0 + wid * 32 + row) * C.dil + C.rho;
        *(u32x4*)(OG + tok * 1536 + C.gh * 64 + ch * 8) = w; }
    }
    if (hi == 0) { const long tok = (long)C.b * SEQ + (long)(C.p0 + wid * 32 + r32) * C.dil + C.rho; LSE[tok * 24 + C.gh] = m_reg + __logf(l_reg); }
    __syncthreads();
  }
#undef DIL_LOADS
}

__device__ void phase_combine(const Params& P) {
  unsigned char* ws = P.ws;
  const bf16_t* OG = (const bf16_t*)(ws + WS_OG); const float* LSE = (const float*)(ws + WS_LSE); const bf16_t* ZD = (const bf16_t*)(ws + WS_ZD);
  bf16_t* A2 = (bf16_t*)(ws + WS_A2);
  const long gtid = (long)blockIdx.x * NTHREADS + otid(), gsz = (long)GRIDX * NTHREADS;
  for (long it = gtid; it < (long)NTOK * 64; it += gsz) {
    const long tok = it >> 6; const int c8 = (int)(it & 63), hh = c8 >> 3, col = c8 * 8;
    const float l0 = LSE[tok * 24 + hh], l1 = LSE[tok * 24 + 8 + hh], l2 = LSE[tok * 24 + 16 + hh];
    const float mx = fmaxf(l0, fmaxf(l1, l2));
    float w0 = __expf(l0 - mx), w1 = __expf(l1 - mx), w2 = __expf(l2 - mx);
    const float inv = 1.f / (w0 + w1 + w2); w0 *= inv; w1 *= inv; w2 *= inv;
    const u32x4 a = *(const u32x4*)(OG + tok * 1536 + col), bq = *(const u32x4*)(OG + tok * 1536 + 512 + col), c = *(const u32x4*)(OG + tok * 1536 + 1024 + col);
    const u32x4 z = *(const u32x4*)(ZD + tok * 512 + col);
    u32x4 r;
#pragma unroll
    for (int e = 0; e < 4; ++e) {
      const float lo = (w0 * bflo(a[e]) + w1 * bflo(bq[e]) + w2 * bflo(c[e])) * bflo(z[e]);
      const float hi_ = (w0 * bfhi(a[e]) + w1 * bfhi(bq[e]) + w2 * bfhi(c[e])) * bfhi(z[e]);
      r[e] = cvtpk(lo, hi_);
    }
    *(u32x4*)(A2 + tok * 512 + col) = r;
  }
}

__device__ void phase_kpe(const Params& P) {
  unsigned char* ws = P.ws;
  const bf16_t* CKVR = (const bf16_t*)(ws + WS_CKVR); bf16_t* MK = (bf16_t*)(ws + WS_MK);
  const float* cosT = (const float*)(ws + WS_COS); const float* sinT = (const float*)(ws + WS_SIN);
  const long gtid = (long)blockIdx.x * NTHREADS + otid(), gsz = (long)GRIDX * NTHREADS;
  for (long it = gtid; it < (long)NTOK * 4; it += gsz) {
    const long tok = it >> 2; const int hq = (int)(it & 3);
    const u32x4 r0 = *(const u32x4*)(CKVR + tok * 256 + 128), r1 = *(const u32x4*)(CKVR + tok * 256 + 136),
                r2 = *(const u32x4*)(CKVR + tok * 256 + 144), r3 = *(const u32x4*)(CKVR + tok * 256 + 152);
    float a[16], bb[16];
#pragma unroll
    for (int e = 0; e < 4; ++e) { a[2 * e] = bflo(r0[e]); a[2 * e + 1] = bfhi(r0[e]); a[8 + 2 * e] = bflo(r1[e]); a[8 + 2 * e + 1] = bfhi(r1[e]);
                                  bb[2 * e] = bflo(r2[e]); bb[2 * e + 1] = bfhi(r2[e]); bb[8 + 2 * e] = bflo(r3[e]); bb[8 + 2 * e + 1] = bfhi(r3[e]); }
    float o1[16], o2[16];
#pragma unroll
    for (int q = 0; q < 8; ++q) {
      const f32x4 c4 = *(const f32x4*)(cosT + tok * 32 + 4 * q), s4 = *(const f32x4*)(sinT + tok * 32 + 4 * q);
      o1[2 * q] = a[2 * q] * c4[0] - bb[2 * q] * s4[0];             o2[2 * q] = bb[2 * q] * c4[0] + a[2 * q] * s4[0];
      o1[2 * q + 1] = a[2 * q + 1] * c4[2] - bb[2 * q + 1] * s4[2]; o2[2 * q + 1] = bb[2 * q + 1] * c4[2] + a[2 * q + 1] * s4[2];
    }
    u32x4 w0, w1, w2, w3;
#pragma unroll
    for (int e = 0; e < 4; ++e) { w0[e] = cvtpk(o1[2 * e], o1[2 * e + 1]); w1[e] = cvtpk(o1[8 + 2 * e], o1[8 + 2 * e + 1]);
                                  w2[e] = cvtpk(o2[2 * e], o2[2 * e + 1]); w3[e] = cvtpk(o2[8 + 2 * e], o2[8 + 2 * e + 1]); }
    const long b = tok / SEQ, s_ = tok % SEQ;
#pragma unroll
    for (int hh = 0; hh < 2; ++hh) { bf16_t* kr = MK + ((b * 8 + hq * 2 + hh) * SEQ + s_) * 96 + 64;
      *(u32x4*)(kr) = w0; *(u32x4*)(kr + 8) = w1; *(u32x4*)(kr + 16) = w2; *(u32x4*)(kr + 24) = w3; }
  }
}

__device__ void phase_mla(const Params& P) {
  unsigned char* ws = P.ws;
  const bf16_t* MQ = (const bf16_t*)(ws + WS_MQ); const bf16_t* MK = (const bf16_t*)(ws + WS_MK); const bf16_t* MV = (const bf16_t*)(ws + WS_MV);
  const bf16_t* ZM = (const bf16_t*)(ws + WS_ZM); bf16_t* A1 = (bf16_t*)(ws + WS_A1);
  const int tid = otid(), wid = tid >> 6, lane = tid & 63, r32 = lane & 31, hi = lane >> 5;
  const float scale = 0.10206207261596577f;
  const int G = GRIDX;
  for (int u0 = blockIdx.x; u0 < 1024; u0 += G) {
    int u = u0;
    if (G == 256) { const int i = u0 >> 8, bx = u0 & 255; u = (i * 8 + (bx & 7)) * 32 + (bx >> 3); }
    const int bh = u >> 5, qb = u & 31, b = bh >> 3, h = bh & 7;
    const bf16_t* Qb = MQ + ((long)bh * SEQ + qb * 256) * 96;
    f32x16 o[2]; float m_reg, l_reg;
    attn_body<6, false>(Qb, 96, MK + (long)bh * SEQ * 96, 96, MV + (long)bh * SEQ * 64, 64, SEQ / 64, scale * LOG2E, 16.f / scale, 0, o, m_reg, l_reg);
    {
      LAS unsigned char* ob = (LAS unsigned char*)smem + AT_WSOFF + 2048 + wid * 4096;
#pragma unroll
      for (int r = 0; r < 16; ++r)
#pragma unroll
        for (int d0 = 0; d0 < 2; ++d0) *(LAS unsigned short*)(ob + crow(r, hi) * 128 + (d0 * 32 + r32) * 2) = (unsigned short)(cvtpk(o[d0][r], 0.f) & 0xffffu);
#pragma unroll
      for (int i = 0; i < 4; ++i) { const int row = (lane >> 3) + 8 * i, ch = lane & 7;
        const u32x4 w = *(const LAS u32x4*)(ob + row * 128 + ch * 16);
        const long idx = ((long)b * SEQ + qb * 256 + wid * 32 + row) * 512 + h * 64 + ch * 8;
        const u32x4 z = *(const u32x4*)(ZM + idx);
        u32x4 rr;
#pragma unroll
        for (int e = 0; e < 4; ++e) rr[e] = cvtpk(bflo(w[e]) * bflo(z[e]), bfhi(w[e]) * bfhi(z[e]));
        *(u32x4*)(A1 + idx) = rr; }
    }
    __syncthreads();
  }
}

__device__ void phase_final_norm(const Params& P) {
  const long gtid = (long)blockIdx.x * NTHREADS + otid(), gsz = (long)GRIDX * NTHREADS;
  const int lane = otid() & 63; const long wv = gtid >> 6, nwv = gsz >> 6;
  f32x4 g4[4];
#pragma unroll
  for (int c = 0; c < 4; ++c) g4[c] = *(const f32x4*)(P.final_g + c * 256 + lane * 4);
  for (long row = wv; row < NTOK; row += nwv) {
    const float* xr = (const float*)(P.ws + WS_PRE) + row * DM; float* orow = P.out + row * DM; f32x4 v[4]; float ss = 0.f;
#pragma unroll
    for (int c = 0; c < 4; ++c) { v[c] = *(const f32x4*)(xr + c * 256 + lane * 4); ss += v[c][0] * v[c][0] + v[c][1] * v[c][1] + v[c][2] * v[c][2] + v[c][3] * v[c][3]; }
    ss = wave_sum(ss);
    const float rs = rsqrtf(ss * (1.f / DM) + RMS_EPS);
#pragma unroll
    for (int c = 0; c < 4; ++c) *(f32x4*)(orow + c * 256 + lane * 4) = v[c] * rs * g4[c];
  }
}

__device__ __forceinline__ void fast_barrier(unsigned* ctr, const unsigned epoch, const unsigned ngrid) {
  asm volatile("s_waitcnt vmcnt(0)" ::: "memory");
  __syncthreads();
  if (threadIdx.x == 0) {
    __builtin_amdgcn_fence(__ATOMIC_RELEASE, "agent");
    asm volatile("s_waitcnt vmcnt(0)" ::: "memory");
    const unsigned target = epoch * ngrid;
    (void)__hip_atomic_fetch_add(ctr, 1u, __ATOMIC_RELAXED, __HIP_MEMORY_SCOPE_AGENT);
    while (__hip_atomic_load(ctr, __ATOMIC_RELAXED, __HIP_MEMORY_SCOPE_AGENT) < target) __builtin_amdgcn_s_sleep(1);
    __builtin_amdgcn_fence(__ATOMIC_ACQUIRE, "agent");
    asm volatile("s_waitcnt vmcnt(0)" ::: "memory");
  }
  __syncthreads();
}
#define XB_XCNT(j)  (64 * (j))
#define XB_XSUB(j)  (1024 + 64 * (j))
#define XB_XGEN(j)  (2048 + 64 * (j))
#define XB_TOP      3072
#define XB_TOPGEN   3136
constexpr int XB_WORDS = 3200;
constexpr int LDS_XB = LDS_BYTES - 16;
__device__ __forceinline__ unsigned xb_ld(unsigned* p)              { return __hip_atomic_load(p, __ATOMIC_RELAXED, __HIP_MEMORY_SCOPE_AGENT); }
__device__ __forceinline__ unsigned xb_add(unsigned* p, unsigned v) { return __hip_atomic_fetch_add(p, v, __ATOMIC_RELAXED, __HIP_MEMORY_SCOPE_AGENT); }
__device__ __forceinline__ unsigned xb_xcc_id() { return (unsigned)__builtin_amdgcn_s_getreg((3 << 11) | 20) & 0xFu; }
__device__ __forceinline__ void xcd_barrier(unsigned* bar, const unsigned ngrid) {
  asm volatile("s_waitcnt vmcnt(0)" ::: "memory");
  __syncthreads();
  if (threadIdx.x == 0) {
    volatile LAS unsigned* st = (volatile LAS unsigned*)((LAS unsigned char*)smem + LDS_XB);
    const unsigned x = xb_xcc_id();
    unsigned nloc = st[0], nx = st[1];
    if (nloc == 0u) {
      for (;;) { unsigned sum = 0u, cnt = 0u, mine = 0u;
#pragma unroll
        for (unsigned j = 0; j < 16; ++j) { const unsigned c = xb_ld(&bar[XB_XCNT(j)]); sum += c; cnt += (c > 0u) ? 1u : 0u; mine = (j == x) ? c : mine; }
        if (sum == ngrid) { nloc = mine; nx = cnt; break; }
        __builtin_amdgcn_s_sleep(1); }
      st[0] = nloc; st[1] = nx;
    }
    const unsigned old = xb_add(&bar[XB_XSUB(x)], 1u);
    const unsigned gen = old / nloc;
    if (old + 1u == (gen + 1u) * nloc) {
      __builtin_amdgcn_fence(__ATOMIC_RELEASE, "agent");
      asm volatile("s_waitcnt vmcnt(0)" ::: "memory");
      const unsigned og = xb_add(&bar[XB_TOP], 1u);
      const unsigned tg = og / nx;
      if (og + 1u == (tg + 1u) * nx) xb_add(&bar[XB_TOPGEN], 1u);
      else while (xb_ld(&bar[XB_TOPGEN]) == tg) __builtin_amdgcn_s_sleep(1);
      __builtin_amdgcn_fence(__ATOMIC_ACQUIRE, "agent");
      xb_add(&bar[XB_XGEN(x)], 1u);
      asm volatile("s_waitcnt vmcnt(0)" ::: "memory");
    } else {
      while (xb_ld(&bar[XB_XGEN(x)]) == gen) __builtin_amdgcn_s_sleep(1);
      __builtin_amdgcn_fence(__ATOMIC_ACQUIRE, "agent");
      asm volatile("s_waitcnt vmcnt(0)" ::: "memory");
    }
  }
  __syncthreads();
}
constexpr int N_PHASES = 11;
template <int PH>
__device__ __forceinline__ void run_phase(const Params& P) {
  unsigned char* ws = P.ws;
  const bf16_t* H = (const bf16_t*)P.out;
  if constexpr (PH == 0) phase_prep(P);
  else if constexpr (PH == 1) phase_gemm<M_IN>(P, H, (const bf16_t*)(ws + WS_WIN), 1024, 12, 20, 12);
  else if constexpr (PH == 2) phase_dilated(P);
  else if constexpr (PH == 3) phase_combine(P);
  else if constexpr (PH == 4) phase_gemm<M_IN>(P, H, (const bf16_t*)(ws + WS_WIN), 1024, 0, 12, 0);
  else if constexpr (PH == 5) {
    phase_gemm<M_UQ>(P, (const bf16_t*)(ws + WS_CQ), (const bf16_t*)(ws + WS_WUQ), 256, 0, 4, 0);
    phase_gemm<M_UKV>(P, (const bf16_t*)(ws + WS_CKVR), (const bf16_t*)(ws + WS_WUKV), 256, 0, 4, 0);
    phase_kpe(P);
  }
  else if constexpr (PH == 6) phase_mla(P);
  else if constexpr (PH == 7) phase_gemm<M_OUT1>(P, (const bf16_t*)(ws + WS_A1), (const bf16_t*)(ws + WS_WOM), 512, 0, 4, 0);
  else if constexpr (PH == 8) phase_gemm<M_OUT2>(P, (const bf16_t*)(ws + WS_A2), (const bf16_t*)(ws + WS_WOD), 512, 0, 4, 0);
  else if constexpr (PH == 9) phase_gemm<M_FINAL>(P, (const bf16_t*)(ws + WS_MERGED), (const bf16_t*)(ws + WS_WOUT), 1024, 0, 4, 0);
  else phase_final_norm(P);
}

#if defined(__HIP_DEVICE_COMPILE__)
__device__ __forceinline__ Params load_params() {
  auto kp = __builtin_amdgcn_kernarg_segment_ptr();
  asm volatile("" : "+s"(kp));
  return *(const __attribute__((address_space(4))) Params*)kp;
}
#else
__device__ __forceinline__ Params load_params() { return Params{}; }
#endif
#if N_LAUNCH_PER_PHASE
template <int PH>
__global__ void __launch_bounds__(NTHREADS) k_phase(Params P) { run_phase<PH>(P); }
#else
__global__ void __launch_bounds__(NTHREADS) k_mega(Params P) {
  cg::grid_group grid = cg::this_grid();
  if (P.ws == nullptr) grid.sync();
#define SEAM(e)  do { const Params Q = load_params(); xcd_barrier((unsigned*)((unsigned char*)Q.out + OUT_BAR_OFF), (unsigned)Q.ngrid); } while (0)
  if (threadIdx.x == 0) { volatile LAS unsigned* st = (volatile LAS unsigned*)((LAS unsigned char*)smem + LDS_XB); st[0] = 0u; st[1] = 0u;
    (void)xb_add((unsigned*)((unsigned char*)P.out + OUT_BAR_OFF) + XB_XCNT(xb_xcc_id()), 1u); }
  __syncthreads();
#define SEAMB(e) do { const Params Q = load_params(); xcd_barrier((unsigned*)(Q.ws + WS_COS), (unsigned)Q.ngrid); } while (0)
#define RUN(k)   do { const Params Q = load_params(); run_phase<k>(Q); } while (0)
  run_phase<0>(P); SEAM(1);
  RUN(1); SEAM(2);
  RUN(2); SEAM(3);
  RUN(3); SEAM(4);
  RUN(4); SEAM(5);
  RUN(5); SEAM(6);
  if (blockIdx.x == 0) { const Params Q = load_params(); const int t = otid();
    for (int w = t; w < XB_WORDS; w += NTHREADS) __hip_atomic_store((unsigned*)(Q.ws + WS_COS) + w, 0u, __ATOMIC_RELAXED, __HIP_MEMORY_SCOPE_AGENT);
    if (t < 128) __hip_atomic_store((unsigned*)(Q.ws + WS_SIN) + t, 0u, __ATOMIC_RELAXED, __HIP_MEMORY_SCOPE_AGENT); }
  RUN(6); SEAM(7);
  { const Params Q = load_params();
    phase_gemm<M_OUT12>(Q, (const bf16_t*)(Q.ws + WS_A1), (const bf16_t*)(Q.ws + WS_WOM), 512, 0, 4, 0); }
  SEAMB(1);
  { const Params Q = load_params();
    phase_gemm<M_FINALN>(Q, (const bf16_t*)(Q.ws + WS_MERGED), (const bf16_t*)(Q.ws + WS_WOUT), 1024, 0, 4, 0); }
}
#endif

template <int PH> static void launch_phase(const Params& p, int grid, hipStream_t stream) {
#if N_LAUNCH_PER_PHASE
  static bool attr = false;
  if (!attr) { (void)hipFuncSetAttribute((const void*)k_phase<PH>, hipFuncAttributeMaxDynamicSharedMemorySize, LDS_BYTES); attr = true; }
  hipLaunchKernelGGL(k_phase<PH>, dim3(grid), dim3(NTHREADS), LDS_BYTES, stream, p);
#endif
}

extern "C" void kernel_launch(void* const* d_in, const int* in_sizes, int n_in, void* d_out, int out_size, void* d_ws, size_t ws_size, hipStream_t stream) {
  static int grid = 0;
  if (grid == 0) {
    if (n_in != 13 || in_sizes[0] != NTOK * DM || out_size != NTOK * DM || ws_size < WS_END) {
      fprintf(stderr, "kernel_launch: unexpected shapes (n_in %d, in0 %d, out %d, ws %zu)\n", n_in, n_in > 0 ? in_sizes[0] : -1, out_size, ws_size); grid = -1; return; }
    int dev = 0, cus = 0;
    (void)hipGetDevice(&dev); (void)hipDeviceGetAttribute(&cus, hipDeviceAttributeMultiprocessorCount, dev);
#if N_LAUNCH_PER_PHASE
    grid = cus > 0 ? cus : 256;
#else
    int per_cu = 0;
    if (hipFuncSetAttribute((const void*)k_mega, hipFuncAttributeMaxDynamicSharedMemorySize, LDS_BYTES) != hipSuccess) { fprintf(stderr, "kernel_launch: hipFuncSetAttribute failed\n"); grid = -1; return; }
    if (hipOccupancyMaxActiveBlocksPerMultiprocessor(&per_cu, (const void*)k_mega, NTHREADS, LDS_BYTES) != hipSuccess || per_cu < 1) { fprintf(stderr, "kernel_launch: occupancy query failed (%d)\n", per_cu); grid = -1; return; }
    grid = cus;
    if (grid % 4 != 0) { fprintf(stderr, "kernel_launch: %d CUs: the fused final-norm exchange needs a grid that is a multiple of 4\n", grid); grid = -1; return; }
#endif
  }
  if (grid < 0) return;
  Params p{};
  p.x = (const float*)d_in[0]; p.pos = (const int*)d_in[1]; p.attn_g = (const float*)d_in[2]; p.w_in = (const float*)d_in[3]; p.b_gate = (const float*)d_in[4];
  p.gq = (const float*)d_in[5]; p.gkv = (const float*)d_in[6]; p.w_uq = (const float*)d_in[7]; p.w_ukv = (const float*)d_in[8]; p.w_om = (const float*)d_in[9];
  p.w_od = (const float*)d_in[10]; p.w_out = (const float*)d_in[11]; p.final_g = (const float*)d_in[12];
  p.out = (float*)d_out; p.ws = (unsigned char*)d_ws;
  for (int i = 0; i < 32; ++i) p.inv_freq[i] = powf(10000.0f, -(float)(2 * i) / 64.0f);
  p.ngrid = grid;
#if N_LAUNCH_PER_PHASE
  launch_phase<0>(p, grid, stream); launch_phase<1>(p, grid, stream); launch_phase<2>(p, grid, stream); launch_phase<3>(p, grid, stream);
  launch_phase<4>(p, grid, stream); launch_phase<5>(p, grid, stream); launch_phase<6>(p, grid, stream); launch_phase<7>(p, grid, stream);
  launch_phase<8>(p, grid, stream); launch_phase<9>(p, grid, stream); launch_phase<10>(p, grid, stream);
#else
  (void)hipMemsetAsync((unsigned char*)d_out + OUT_BAR_OFF, 0, XB_WORDS * 4, stream);
  void* args[] = {&p};
  hipError_t e = hipLaunchCooperativeKernel((const void*)k_mega, dim3(grid), dim3(NTHREADS), args, LDS_BYTES, stream);
  if (e != hipSuccess) fprintf(stderr, "cooperative launch failed: %s (grid %d)\n", hipGetErrorString(e), grid);
#endif
}
```
